# Optimizing an MI355X kernel written in HIP

```python
import math
import jax, jax.numpy as jnp
from jax import lax
import numpy as np

D_MODEL = 1024
BATCH = 8
SEQ = 2048
DEPTH = 4
DEC_BATCH = 128
DEC_SEQ = 8
PAST_LEN = 16384
PAGE_SIZE = 128

MIX_DIM = 2 * D_MODEL
CONV_WIDTH = 4
SSD_DIM = D_MODEL
SSD_HEADDIM = 64
SSD_HEADS = SSD_DIM // SSD_HEADDIM
SSD_GROUPS = 4
SSD_HPG = SSD_HEADS // SSD_GROUPS
SSD_STATE = 128
SSD_CONV_DIM = SSD_DIM + 2 * SSD_GROUPS * SSD_STATE
SSD_CHUNK = 128
LRU_DIM = D_MODEL // 2
LRU_BLOCKS = 8
LRU_BLOCK_DIM = LRU_DIM // LRU_BLOCKS
LRU_C = 8.0
S5_DIM = D_MODEL // 2
S5_GROUP = 16
S5_NGROUPS = S5_DIM // S5_GROUP
S5_STATE = 64
EPS = 1e-6

OFF_XBC = SSD_DIM
OFF_DT = OFF_XBC + SSD_CONV_DIM
OFF_LRU = OFF_DT + SSD_HEADS
OFF_LRU_G = OFF_LRU + LRU_DIM
OFF_S5 = OFF_LRU_G + LRU_DIM
OFF_S5_G = OFF_S5 + S5_DIM
IN_DIM = OFF_S5_G + S5_DIM
SPLITS = (OFF_XBC, OFF_DT, OFF_LRU, OFF_LRU_G, OFF_S5, OFF_S5_G)

kernel_name = "hymba_ssd_rglru_s5_step"


def rmsnorm(x, g):
    xf = x.astype(jnp.float32)
    return xf * lax.rsqrt(jnp.mean(xf * xf, axis=-1, keepdims=True) + EPS) * g


def causal_conv(x, prev, w, b):
    l = x.shape[1]
    xp = jnp.concatenate([prev, x], axis=1)
    y = b + sum(w[k] * xp[:, k:k + l] for k in range(CONV_WIDTH))
    return y, xp[:, l:]


def ssd_scan(x, dt, a, bmat, cmat, h0):
    bsz, l = x.shape[:2]
    q = l if l <= SSD_CHUNK else math.gcd(l, SSD_CHUNK)
    nc = l // q
    xc = x.reshape(bsz, nc, q, SSD_GROUPS, SSD_HPG, SSD_HEADDIM)
    dtc = dt.reshape(bsz, nc, q, SSD_GROUPS, SSD_HPG)
    bc = bmat.reshape(bsz, nc, q, SSD_GROUPS, SSD_STATE)
    cc = cmat.reshape(bsz, nc, q, SSD_GROUPS, SSD_STATE)
    acum = jnp.moveaxis(jnp.cumsum(dtc * a.reshape(SSD_GROUPS, SSD_HPG), axis=2), 2, -1)
    dt_t = jnp.moveaxis(dtc, 2, -1)
    diff = acum[..., :, None] - acum[..., None, :]
    causal = jnp.tril(jnp.ones((q, q), dtype=bool))
    decay = jnp.where(causal, jnp.exp(jnp.where(causal, diff, 0.0)), 0.0)
    scores = jnp.einsum('bcqgn,bcsgn->bcgqs', cc, bc)
    y_diag = jnp.einsum('bcgqs,bcgrqs,bcgrs,bcsgrp->bcqgrp', scores, decay, dt_t, xc)
    to_end = jnp.exp(acum[..., -1:] - acum)
    chunk_states = jnp.einsum('bcsgn,bcgrs,bcsgrp->bcgrpn', bc, to_end * dt_t, xc)
    chunk_decay = jnp.exp(acum[..., -1])

    def step(h, inp):
        dec, st = inp
        return dec[..., None, None] * h + st, h

    h_last, h_prev = lax.scan(
        step, h0.reshape(bsz, SSD_GROUPS, SSD_HPG, SSD_HEADDIM, SSD_STATE),
        (jnp.moveaxis(chunk_decay, 1, 0), jnp.moveaxis(chunk_states, 1, 0)))
    h_prev = jnp.moveaxis(h_prev, 0, 1)
    y_off = jnp.einsum('bcqgn,bcgrpn,bcgrq->bcqgrp', cc, h_prev, jnp.exp(acum))
    y = (y_diag + y_off).reshape(bsz, l, SSD_HEADS, SSD_HEADDIM)
    return y, h_last.reshape(bsz, SSD_HEADS, SSD_HEADDIM, SSD_STATE)


def linear_scan(a, b, h0):
    b = b.at[:, 0].add(a[:, 0] * h0)

    def combine(e1, e2):
        a1, b1 = e1
        a2, b2 = e2
        return a1 * a2, a2 * b1 + b2

    _, h = lax.associative_scan(combine, (a, b), axis=1)
    return h


def complex_linear_scan(ar, ai, br, bi, h0r, h0i):
    br = br.at[:, 0].add(ar[:, 0] * h0r - ai[:, 0] * h0i)
    bi = bi.at[:, 0].add(ar[:, 0] * h0i + ai[:, 0] * h0r)

    def combine(e1, e2):
        ar1, ai1, br1, bi1 = e1
        ar2, ai2, br2, bi2 = e2
        return (ar1 * ar2 - ai1 * ai2, ar1 * ai2 + ai1 * ar2,
                ar2 * br1 - ai2 * bi1 + br2, ar2 * bi1 + ai2 * br1 + bi2)

    _, _, hr, hi = lax.associative_scan(combine, (ar, ai, br, bi), axis=1)
    return hr, hi


def s5_mixer(u, lam_re, lam_im, log_dt, b_re, b_im, c_re, c_im, d, h0r, h0i):
    bsz, l, _ = u.shape
    ug = u.reshape(bsz, l, S5_NGROUPS, S5_GROUP)
    delta = jnp.exp(log_dt)[:, None]
    mag = jnp.exp(lam_re * delta)
    abar_re = mag * jnp.cos(lam_im * delta)
    abar_im = mag * jnp.sin(lam_im * delta)
    denom = lam_re * lam_re + lam_im * lam_im
    nr = abar_re - 1.0
    ni = abar_im
    coef_re = (nr * lam_re + ni * lam_im) / denom
    coef_im = (ni * lam_re - nr * lam_im) / denom
    bbar_re = coef_re[..., None] * b_re - coef_im[..., None] * b_im
    bbar_im = coef_re[..., None] * b_im + coef_im[..., None] * b_re
    bu_re = jnp.einsum('blgh,gph->blgp', ug, bbar_re)
    bu_im = jnp.einsum('blgh,gph->blgp', ug, bbar_im)
    ar = jnp.broadcast_to(abar_re, bu_re.shape)
    ai = jnp.broadcast_to(abar_im, bu_re.shape)
    hr, hi = complex_linear_scan(ar, ai, bu_re, bu_im, h0r, h0i)
    y = jnp.einsum('blgp,ghp->blgh', hr, c_re) - jnp.einsum('blgp,ghp->blgh', hi, c_im)
    y = y.reshape(bsz, l, S5_DIM) + d * u
    return y, hr[:, -1], hi[:, -1]


def mixer_layer(x, states, p):
    ssd_h0, ssd_conv0, lru_h0, lru_conv0, s5_h0r, s5_h0i = states
    bsz, l, _ = x.shape
    h = rmsnorm(x, p['norm_g'])
    proj = h @ p['w_in']
    z, xbc, dt_raw, lru_x, lru_gate, s5_u, s5_gate = jnp.split(proj, SPLITS, axis=-1)

    xbc, ssd_conv_new = causal_conv(xbc, ssd_conv0, p['ssd_conv_w'], p['ssd_conv_b'])
    xbc = jax.nn.silu(xbc)
    xs, bm, cm = jnp.split(xbc, (SSD_DIM, SSD_DIM + SSD_GROUPS * SSD_STATE), axis=-1)
    dt = jax.nn.softplus(dt_raw + p['ssd_dt_bias'])
    a = -jnp.exp(p['ssd_a_log'])
    xh = xs.reshape(bsz, l, SSD_HEADS, SSD_HEADDIM)
    y, ssd_h = ssd_scan(xh, dt, a, bm.reshape(bsz, l, SSD_GROUPS, SSD_STATE),
                        cm.reshape(bsz, l, SSD_GROUPS, SSD_STATE), ssd_h0)
    y = y + p['ssd_d'][:, None] * xh
    y_ssd = rmsnorm(y.reshape(bsz, l, SSD_DIM) * jax.nn.silu(z), p['ssd_norm_g'])

    xr, lru_conv_new = causal_conv(lru_x, lru_conv0, p['lru_conv_w'], p['lru_conv_b'])
    xb = xr.reshape(bsz, l, LRU_BLOCKS, LRU_BLOCK_DIM)
    r = jax.nn.sigmoid(jnp.einsum('blki,kij->blkj', xb, p['lru_wa']).reshape(bsz, l, LRU_DIM) + p['lru_ba'])
    gi = jax.nn.sigmoid(jnp.einsum('blki,kij->blkj', xb, p['lru_wx']).reshape(bsz, l, LRU_DIM) + p['lru_bx'])
    log_a = -LRU_C * r * jax.nn.softplus(-p['lru_lambda'])
    a_t = jnp.exp(log_a)
    gain = jnp.sqrt(jnp.maximum(-jnp.expm1(2.0 * log_a), 0.0))
    hs = linear_scan(a_t, gain * gi * xr, lru_h0)
    y_lru = hs * jax.nn.silu(lru_gate)

    ys5, s5_hr, s5_hi = s5_mixer(s5_u, p['s5_lambda_re'], p['s5_lambda_im'], p['s5_log_dt'],
                                 p['s5_b_re'], p['s5_b_im'], p['s5_c_re'], p['s5_c_im'],
                                 p['s5_d'], s5_h0r, s5_h0i)
    ys5 = jax.nn.gelu(ys5)
    ys5 = ys5 * jax.nn.sigmoid(ys5 @ p['s5_glu_w'] + p['s5_glu_b'])
    y_s5 = ys5 * jax.nn.silu(s5_gate)

    out = jnp.concatenate([y_ssd, y_lru, y_s5], axis=-1) @ p['w_out']
    return x + out, (ssd_h, ssd_conv_new, hs[:, -1], lru_conv_new, s5_hr, s5_hi)


def setup_inputs(seed: int = 0) -> dict:
    key = jax.random.key(seed)
    ks = iter(jax.random.split(key, 48))
    f32 = jnp.float32

    def nrm(shape, scale):
        return scale * jax.random.normal(next(ks), shape, f32)

    def uni(shape, lo, hi):
        return jax.random.uniform(next(ks), shape, f32, lo, hi)

    x_prompt = nrm((BATCH, SEQ, D_MODEL), 1.0)
    x_sample = nrm((DEC_BATCH, DEC_SEQ, D_MODEL), 1.0)
    state_ssd = nrm((DEPTH, DEC_BATCH, SSD_HEADS, SSD_HEADDIM, SSD_STATE), 0.1)
    state_ssd_conv = nrm((DEPTH, DEC_BATCH, CONV_WIDTH - 1, SSD_CONV_DIM), 1.0)
    state_lru = nrm((DEPTH, DEC_BATCH, LRU_DIM), 0.5)
    state_lru_conv = nrm((DEPTH, DEC_BATCH, CONV_WIDTH - 1, LRU_DIM), 1.0)
    state_s5_re = nrm((DEPTH, DEC_BATCH, S5_NGROUPS, S5_STATE), 0.5)
    state_s5_im = nrm((DEPTH, DEC_BATCH, S5_NGROUPS, S5_STATE), 0.5)

    norm_g = 1.0 + nrm((DEPTH, D_MODEL), 0.02)
    w_in = nrm((DEPTH, D_MODEL, IN_DIM), D_MODEL ** -0.5)
    ssd_conv_w = nrm((DEPTH, CONV_WIDTH, SSD_CONV_DIM), CONV_WIDTH ** -0.5)
    ssd_conv_b = nrm((DEPTH, SSD_CONV_DIM), 0.02)
    dt0 = jnp.exp(uni((DEPTH, SSD_HEADS), math.log(1e-3), math.log(1e-1)))
    ssd_dt_bias = dt0 + jnp.log(-jnp.expm1(-dt0))
    ssd_a_log = jnp.log(uni((DEPTH, SSD_HEADS), 1.0, 16.0))
    ssd_d = 1.0 + nrm((DEPTH, SSD_HEADS), 0.02)
    ssd_norm_g = 1.0 + nrm((DEPTH, SSD_DIM), 0.02)
    lru_conv_w = nrm((DEPTH, CONV_WIDTH, LRU_DIM), CONV_WIDTH ** -0.5)
    lru_conv_b = nrm((DEPTH, LRU_DIM), 0.02)
    lru_wa = nrm((DEPTH, LRU_BLOCKS, LRU_BLOCK_DIM, LRU_BLOCK_DIM), LRU_BLOCK_DIM ** -0.5)
    lru_ba = nrm((DEPTH, LRU_DIM), 0.02)
    lru_wx = nrm((DEPTH, LRU_BLOCKS, LRU_BLOCK_DIM, LRU_BLOCK_DIM), LRU_BLOCK_DIM ** -0.5)
    lru_bx = nrm((DEPTH, LRU_DIM), 0.02)
    u_a = uni((DEPTH, LRU_DIM), 0.9, 0.999)
    lru_lambda = jnp.log(u_a) - jnp.log1p(-u_a)
    s5_lambda_re = -0.5 + nrm((DEPTH, S5_NGROUPS, S5_STATE), 0.01)
    s5_lambda_im = jnp.pi * jnp.arange(S5_STATE, dtype=f32) + nrm((DEPTH, S5_NGROUPS, S5_STATE), 0.01)
    s5_log_dt = uni((DEPTH, S5_NGROUPS), math.log(1e-3), math.log(1e-1))
    s5_b_re = nrm((DEPTH, S5_NGROUPS, S5_STATE, S5_GROUP), (2 * S5_GROUP) ** -0.5)
    s5_b_im = nrm((DEPTH, S5_NGROUPS, S5_STATE, S5_GROUP), (2 * S5_GROUP) ** -0.5)
    s5_c_re = nrm((DEPTH, S5_NGROUPS, S5_GROUP, S5_STATE), S5_STATE ** -0.5)
    s5_c_im = nrm((DEPTH, S5_NGROUPS, S5_GROUP, S5_STATE), S5_STATE ** -0.5)
    s5_d = nrm((DEPTH, S5_DIM), 1.0)
    s5_glu_w = nrm((DEPTH, S5_DIM, S5_DIM), S5_DIM ** -0.5)
    s5_glu_b = nrm((DEPTH, S5_DIM), 0.02)
    w_out = nrm((DEPTH, MIX_DIM, D_MODEL), MIX_DIM ** -0.5)
    final_norm_g = 1.0 + nrm((D_MODEL,), 0.02)
    return {
        "x_prompt": x_prompt, "x_sample": x_sample,
        "state_ssd": state_ssd, "state_ssd_conv": state_ssd_conv,
        "state_lru": state_lru, "state_lru_conv": state_lru_conv,
        "state_s5_re": state_s5_re, "state_s5_im": state_s5_im,
        "norm_g": norm_g, "w_in": w_in,
        "ssd_conv_w": ssd_conv_w, "ssd_conv_b": ssd_conv_b, "ssd_dt_bias": ssd_dt_bias,
        "ssd_a_log": ssd_a_log, "ssd_d": ssd_d, "ssd_norm_g": ssd_norm_g,
        "lru_conv_w": lru_conv_w, "lru_conv_b": lru_conv_b, "lru_wa": lru_wa, "lru_ba": lru_ba,
        "lru_wx": lru_wx, "lru_bx": lru_bx, "lru_lambda": lru_lambda,
        "s5_lambda_re": s5_lambda_re, "s5_lambda_im": s5_lambda_im, "s5_log_dt": s5_log_dt,
        "s5_b_re": s5_b_re, "s5_b_im": s5_b_im, "s5_c_re": s5_c_re, "s5_c_im": s5_c_im,
        "s5_d": s5_d, "s5_glu_w": s5_glu_w, "s5_glu_b": s5_glu_b,
        "w_out": w_out, "final_norm_g": final_norm_g,
    }


def reference(x_prompt, x_sample, state_ssd, state_ssd_conv, state_lru, state_lru_conv,
              state_s5_re, state_s5_im, norm_g, w_in, ssd_conv_w, ssd_conv_b, ssd_dt_bias,
              ssd_a_log, ssd_d, ssd_norm_g, lru_conv_w, lru_conv_b, lru_wa, lru_ba, lru_wx,
              lru_bx, lru_lambda, s5_lambda_re, s5_lambda_im, s5_log_dt, s5_b_re, s5_b_im,
              s5_c_re, s5_c_im, s5_d, s5_glu_w, s5_glu_b, w_out, final_norm_g):
    f32 = jnp.float32
    bp = x_prompt.shape[0]
    xp = x_prompt.astype(f32)
    xs = x_sample.astype(f32)
    zero_states = (
        jnp.zeros((bp, SSD_HEADS, SSD_HEADDIM, SSD_STATE), f32),
        jnp.zeros((bp, CONV_WIDTH - 1, SSD_CONV_DIM), f32),
        jnp.zeros((bp, LRU_DIM), f32),
        jnp.zeros((bp, CONV_WIDTH - 1, LRU_DIM), f32),
        jnp.zeros((bp, S5_NGROUPS, S5_STATE), f32),
        jnp.zeros((bp, S5_NGROUPS, S5_STATE), f32),
    )
    new_p = ([], [], [], [], [], [])
    new_s = ([], [], [], [], [], [])
    for i in range(DEPTH):
        layer = {
            'norm_g': norm_g[i], 'w_in': w_in[i],
            'ssd_conv_w': ssd_conv_w[i], 'ssd_conv_b': ssd_conv_b[i], 'ssd_dt_bias': ssd_dt_bias[i],
            'ssd_a_log': ssd_a_log[i], 'ssd_d': ssd_d[i], 'ssd_norm_g': ssd_norm_g[i],
            'lru_conv_w': lru_conv_w[i], 'lru_conv_b': lru_conv_b[i], 'lru_wa': lru_wa[i],
            'lru_ba': lru_ba[i], 'lru_wx': lru_wx[i], 'lru_bx': lru_bx[i], 'lru_lambda': lru_lambda[i],
            's5_lambda_re': s5_lambda_re[i], 's5_lambda_im': s5_lambda_im[i], 's5_log_dt': s5_log_dt[i],
            's5_b_re': s5_b_re[i], 's5_b_im': s5_b_im[i], 's5_c_re': s5_c_re[i], 's5_c_im': s5_c_im[i],
            's5_d': s5_d[i], 's5_glu_w': s5_glu_w[i], 's5_glu_b': s5_glu_b[i], 'w_out': w_out[i],
        }
        p = {k: v.astype(f32) for k, v in layer.items()}
        sample_states = (state_ssd[i].astype(f32), state_ssd_conv[i].astype(f32),
                         state_lru[i].astype(f32), state_lru_conv[i].astype(f32),
                         state_s5_re[i].astype(f32), state_s5_im[i].astype(f32))
        xp, sp = mixer_layer(xp, zero_states, p)
        xs, ss = mixer_layer(xs, sample_states, p)
        for j in range(6):
            new_p[j].append(sp[j])
            new_s[j].append(ss[j])
    fg = final_norm_g.astype(f32)
    y_prompt = rmsnorm(xp, fg).astype(x_prompt.dtype)
    y_sample = rmsnorm(xs, fg).astype(x_sample.dtype)
    ssd_p = jnp.stack(new_p[0]).astype(state_ssd.dtype)
    ssd_s = jnp.stack(new_s[0]).astype(state_ssd.dtype)
    ssd_conv_p = jnp.stack(new_p[1]).astype(state_ssd_conv.dtype)
    ssd_conv_s = jnp.stack(new_s[1]).astype(state_ssd_conv.dtype)
    lru_p = jnp.stack(new_p[2]).astype(state_lru.dtype)
    lru_s = jnp.stack(new_s[2]).astype(state_lru.dtype)
    lru_conv_p = jnp.stack(new_p[3]).astype(state_lru_conv.dtype)
    lru_conv_s = jnp.stack(new_s[3]).astype(state_lru_conv.dtype)
    s5_re_p = jnp.stack(new_p[4]).astype(state_s5_re.dtype)
    s5_re_s = jnp.stack(new_s[4]).astype(state_s5_re.dtype)
    s5_im_p = jnp.stack(new_p[5]).astype(state_s5_im.dtype)
    s5_im_s = jnp.stack(new_s[5]).astype(state_s5_im.dtype)
    return (y_prompt, y_sample, ssd_p, ssd_s, ssd_conv_p, ssd_conv_s, lru_p, lru_s,
            lru_conv_p, lru_conv_s, s5_re_p, s5_re_s, s5_im_p, s5_im_s)
```

```cpp
#include <hip/hip_runtime.h>
#include <hip/hip_cooperative_groups.h>
#include <cstdio>
#include <cstdint>
namespace cg = cooperative_groups;

#define LAS __attribute__((address_space(3)))
typedef unsigned short bf16_t;
typedef float f32x4 __attribute__((ext_vector_type(4)));
typedef float f32x2 __attribute__((ext_vector_type(2)));
typedef unsigned u32x4 __attribute__((ext_vector_type(4)));
typedef unsigned u32x2 __attribute__((ext_vector_type(2)));

constexpr int D = 1024, NP = 16384, NSR = 1024, MT = NP + NSR, DEPTH = 4, NPROJ = 5120, INDIM = 5136;
constexpr int SEQ = 2048, DSEQ = 8, BATCH = 8, DBATCH = 128;
constexpr float EPS = 1e-6f;
constexpr int PC_Z = 0, PC_X = 1024, PC_B = 2048, PC_C = 2560, PC_LX = 3072, PC_LG = 3584, PC_SU = 4096, PC_SG = 4608;
constexpr size_t O_YP = 0, O_YS = O_YP + (size_t)NP * D, O_SSDP = O_YS + (size_t)NSR * D, O_SSDS = O_SSDP + (size_t)DEPTH * BATCH * 16 * 64 * 128,
    O_SCP = O_SSDS + (size_t)DEPTH * DBATCH * 16 * 64 * 128, O_SCS = O_SCP + (size_t)DEPTH * BATCH * 3 * 2048, O_LRUP = O_SCS + (size_t)DEPTH * DBATCH * 3 * 2048,
    O_LRUS = O_LRUP + (size_t)DEPTH * BATCH * 512, O_LCP = O_LRUS + (size_t)DEPTH * DBATCH * 512, O_LCS = O_LCP + (size_t)DEPTH * BATCH * 3 * 512,
    O_S5RP = O_LCS + (size_t)DEPTH * DBATCH * 3 * 512, O_S5RS = O_S5RP + (size_t)DEPTH * BATCH * 2048, O_S5IP = O_S5RS + (size_t)DEPTH * DBATCH * 2048,
    O_S5IS = O_S5IP + (size_t)DEPTH * BATCH * 2048, O_END = O_S5IS + (size_t)DEPTH * DBATCH * 2048;
constexpr size_t WS_CTR = 0, WS_WTIN = 4096, WS_WTOUT = WS_WTIN + (size_t)DEPTH * NPROJ * D * 2, WS_WTGLU = WS_WTOUT + (size_t)DEPTH * D * 2048 * 2,
    WS_HB = WS_WTGLU + (size_t)DEPTH * 512 * 512 * 2, WS_PROJ = WS_HB + (size_t)MT * D * 2, WS_DTRAW = WS_PROJ + (size_t)MT * NPROJ * 2,
    WS_A2 = WS_DTRAW + (size_t)MT * 16 * 4, WS_G5 = WS_A2 + (size_t)MT * 2048 * 2, WS_XB = WS_G5 + (size_t)MT * 512 * 2, WS_SSQ = WS_XB + (size_t)MT * D * 4,
    WS_END = WS_SSQ + (size_t)MT * 16 * 4;
constexpr int LDS_BYTES = 131072;
constexpr int NPH = 1 + 5 * DEPTH;

struct Args { const float* in[35]; float* out; unsigned char* ws; int ph_lo, ph_hi; };
#define CAS __attribute__((address_space(4)))
typedef const CAS Args* AP;

__device__ __forceinline__ float bf2f(bf16_t v) { return __uint_as_float(((unsigned)v) << 16); }
__device__ __forceinline__ bf16_t f2bf(float f) { unsigned u = __float_as_uint(f); u += 0x7FFFu + ((u >> 16) & 1u); return (bf16_t)(u >> 16); }
__device__ __forceinline__ unsigned pk2(float lo, float hi) { return (unsigned)f2bf(lo) | ((unsigned)f2bf(hi) << 16); }
__device__ __forceinline__ float lo16(unsigned w) { return __uint_as_float(w << 16); }
__device__ __forceinline__ float hi16(unsigned w) { return __uint_as_float(w & 0xffff0000u); }
__device__ __forceinline__ float sigmoid_f(float x) { return 1.f / (1.f + __expf(-x)); }
__device__ __forceinline__ float silu_f(float x) { return x / (1.f + __expf(-x)); }
__device__ __forceinline__ float softplus_f(float x) { return fmaxf(x, 0.f) + log1pf(__expf(-fabsf(x))); }
__device__ __forceinline__ float gelu_f(float x) { const float t = tanhf(0.7978845608028654f * (x + 0.044715f * x * x * x)); return 0.5f * x * (1.f + t); }
__device__ __forceinline__ float wave_sum(float v) {
#pragma unroll
    for (int o = 1; o < 64; o <<= 1) v += __shfl_xor(v, o);
    return v;
}

namespace pg8 {
#define PG8_LAS __attribute__((address_space(3)))
typedef unsigned short bf16_t;
typedef short bf16x8 __attribute__((ext_vector_type(8)));
typedef float f32x4 __attribute__((ext_vector_type(4)));
typedef unsigned u32x4 __attribute__((ext_vector_type(4)));
constexpr int BM = 256, BK = 64, HALF = 128, HTB = HALF * BK * 2  , STAGE_BYTES = 8 * HTB, NXCD = 8, WGM = 8;

__host__ __device__ __forceinline__ int lds_byte(int r, int c) { const int st = (r >> 4) * 2 + (c >> 5), rr = r & 15, cc = c & 31, ob = rr * 64 + cc * 2; return st * 1024 + (ob ^ (((ob >> 9) & 1) << 5)); }
__host__ __device__ __forceinline__ void stage_rc(int b, int& R, int& C) { const int st = b / 1024, sb = b % 1024, swz = sb ^ (((sb >> 9) & 1) << 5); R = (st >> 1) * 16 + swz / 64; C = (st & 1) * 32 + (swz % 64) / 2; }
__host__ __device__ __forceinline__ int perm32(int rho) { const int n = rho >> 4, i = rho & 15; return 8 * (i >> 2) + 4 * n + (i & 3); }

struct Unit { int pm, pn; };
struct Gemm { const bf16_t* A; const bf16_t* Bt; int M, N, K; };

struct StaticOrder {
    int nM, nN, nwg, G, c;
    __host__ __device__ void init(int M, int N, int G_, int c_) { nM = M / BM; nN = N / BM; nwg = nM * nN; G = G_; c = c_; }
    __host__ __device__ bool next(int i, Unit& u) const {
        const long L = (long)i * G + c; if (L >= nwg) return false;
        int wgid = (int)L; { const int q = nwg / NXCD, r = nwg % NXCD, xcd = wgid % NXCD, off = wgid / NXCD; wgid = (xcd < r ? xcd * (q + 1) : r * (q + 1) + (xcd - r) * q) + off; }
        const int nig = WGM * nN, gid = wgid / nig, fm = gid * WGM, gsz = (nM - fm) < WGM ? (nM - fm) : WGM;
        u.pm = fm + ((wgid % nig) % gsz); u.pn = (wgid % nig) / gsz; return true;
    }
    __device__ __forceinline__ void a_ready(const Unit&) const {}
    __device__ __forceinline__ void done(const Unit&) const {}
};

__device__ __forceinline__ unsigned cvt_pk_bf16(float lo, float hi) { unsigned r; asm volatile("v_cvt_pk_bf16_f32 %0, %1, %2" : "=v"(r) : "v"(lo), "v"(hi)); return r; }
struct EpiProj {
    static constexpr bool PERM = true, AFTER_DRAIN = false;
    bf16_t* O; int ldc;
    __device__ __forceinline__ void operator()(const f32x4 (&acc)[2][2][4][2], const Unit& u, int wr, int wc, int fr, int fq) const {
        const int row0 = u.pm * BM + wr * 64 + fr, col0 = u.pn * BM + wc * 32 + 8 * fq;
#pragma unroll
        for (int ai = 0; ai < 2; ++ai)
#pragma unroll
            for (int m = 0; m < 4; ++m) { bf16_t* rowp = O + (size_t)(row0 + ai * HALF + m * 16) * ldc + col0;
#pragma unroll
                for (int bj = 0; bj < 2; ++bj) { const f32x4 v0 = acc[ai][bj][m][0], v1 = acc[ai][bj][m][1];
                    u32x4 w; w.x = cvt_pk_bf16(v0[0], v0[1]); w.y = cvt_pk_bf16(v0[2], v0[3]); w.z = cvt_pk_bf16(v1[0], v1[1]); w.w = cvt_pk_bf16(v1[2], v1[3]);
                    *(u32x4*)(rowp + bj * HALF) = w; } }
    }
};
struct EpiGlu {
    static constexpr bool PERM = true, AFTER_DRAIN = false;
    const bf16_t* G5; const bf16_t* proj; bf16_t* A2; const float* bias;
    __device__ __forceinline__ void operator()(const f32x4 (&acc)[2][2][4][2], const Unit& u, int wr, int wc, int fr, int fq) const {
        const int row0 = u.pm * BM + wr * 64 + fr, col0 = u.pn * BM + wc * 32 + 8 * fq;
#pragma unroll
        for (int bj = 0; bj < 2; ++bj) {
            const int col = col0 + bj * HALF;
            const f32x4 b0 = *(const f32x4*)(bias + col), b1 = *(const f32x4*)(bias + col + 4);
#pragma unroll
            for (int ai = 0; ai < 2; ++ai)
#pragma unroll
                for (int m = 0; m < 4; ++m) { const size_t row = (size_t)(row0 + ai * HALF + m * 16);
                    const u32x4 g = *(const u32x4*)(G5 + row * 512 + col); const u32x4 s = *(const u32x4*)(proj + row * NPROJ + PC_SG + col);
                    const f32x4 v0 = acc[ai][bj][m][0] + b0, v1 = acc[ai][bj][m][1] + b1;
                    float o[8];
                    o[0] = lo16(g.x) * sigmoid_f(v0[0]) * silu_f(lo16(s.x)); o[1] = hi16(g.x) * sigmoid_f(v0[1]) * silu_f(hi16(s.x));
                    o[2] = lo16(g.y) * sigmoid_f(v0[2]) * silu_f(lo16(s.y)); o[3] = hi16(g.y) * sigmoid_f(v0[3]) * silu_f(hi16(s.y));
                    o[4] = lo16(g.z) * sigmoid_f(v1[0]) * silu_f(lo16(s.z)); o[5] = hi16(g.z) * sigmoid_f(v1[1]) * silu_f(hi16(s.z));
                    o[6] = lo16(g.w) * sigmoid_f(v1[2]) * silu_f(lo16(s.w)); o[7] = hi16(g.w) * sigmoid_f(v1[3]) * silu_f(hi16(s.w));
                    u32x4 w; w.x = cvt_pk_bf16(o[0], o[1]); w.y = cvt_pk_bf16(o[2], o[3]); w.z = cvt_pk_bf16(o[4], o[5]); w.w = cvt_pk_bf16(o[6], o[7]);
                    *(u32x4*)(A2 + row * 2048 + 1536 + col) = w; }
        }
    }
};
struct EpiRes {
    static constexpr bool PERM = false, AFTER_DRAIN = false;
    const float* srcP; const float* srcS; float* xout;
    __device__ __forceinline__ void operator()(const f32x4 (&acc)[2][2][4][2], const Unit& u, int wr, int wc, int fr, int fq) const {
        const int row0 = u.pm * BM + wr * 64 + fr, col0 = u.pn * BM + wc * 32 + 4 * fq;
        const float* sb = (u.pm * BM < NP) ? srcP : (srcS - (size_t)NP * D);
#pragma unroll
        for (int ai = 0; ai < 2; ++ai)
#pragma unroll
            for (int m = 0; m < 4; ++m) { const size_t ro = (size_t)(row0 + ai * HALF + m * 16) * D + col0;
#pragma unroll
                for (int bj = 0; bj < 2; ++bj)
#pragma unroll
                    for (int n = 0; n < 2; ++n) { const f32x4 r = *(const f32x4*)(sb + ro + bj * HALF + n * 16); *(f32x4*)(xout + ro + bj * HALF + n * 16) = acc[ai][bj][m][n] + r; } }
    }
};

template <class Epi, class Sched, bool ALIGN_EPI = false, bool SP2 = false>
__device__ __forceinline__ void gemm_phase(PG8_LAS unsigned char* lds, const Gemm g, const Sched& S, const Epi& E) {
    const int tid = threadIdx.x, wid = __builtin_amdgcn_readfirstlane(tid >> 6), lane = tid & 63, wr = wid >> 2, wc = wid & 3, fr = lane & 15, fq = lane >> 4;
    const int K = g.K, nt = K / BK;
    unsigned voffA[2], voffB[2];
#pragma unroll
    for (int i = 0; i < 2; ++i) { int R, C; stage_rc(tid * 16 + i * 8192, R, C); const int Rb = Epi::PERM ? ((R & ~31) + perm32(R & 31)) : R;
        voffA[i] = (unsigned)(R * K + C) * 2u; voffB[i] = (unsigned)(Rb * K + C) * 2u; }
    const size_t kstep = (size_t)(BK * 2);
    const size_t hstep = (size_t)HALF * K * 2;
    const size_t tstep = 2 * hstep;
    const unsigned ldsw = (unsigned)wid * 1024u;
    const int aoff = lds_byte(wr * 64 + fr, fq * 8), boff = lds_byte(wc * 32 + fr, fq * 8);
#define PG8_SA(b, h) (((b) * 2 + (h)) * HTB)
#define PG8_SB(b, h) ((4 + (b) * 2 + (h)) * HTB)
#define PG8_STAGE(bufoff, gbase, voff) do { _Pragma("unroll") for (int _i = 0; _i < 2; ++_i) \
        __builtin_amdgcn_global_load_lds((const unsigned*)((const char*)(gbase) + (voff)[_i]), (PG8_LAS unsigned*)(lds + (bufoff) + ldsw + _i * 8192), 16, 0, 0); } while (0)
#define PG8_LDA(dst, b, h) do { _Pragma("unroll") for (int m = 0; m < 4; ++m) _Pragma("unroll") for (int k = 0; k < 2; ++k) dst[m][k] = *(const PG8_LAS bf16x8*)(lds + PG8_SA(b, h) + aoff + m * 2048 + k * 1024); } while (0)
#define PG8_LDB(dst, b, h) do { _Pragma("unroll") for (int n = 0; n < 2; ++n) _Pragma("unroll") for (int k = 0; k < 2; ++k) dst[n][k] = *(const PG8_LAS bf16x8*)(lds + PG8_SB(b, h) + boff + n * 2048 + k * 1024); } while (0)
#define PG8_MMA(ai, bj, At, Bt) do { __builtin_amdgcn_s_setprio(1); _Pragma("unroll") for (int m = 0; m < 4; ++m) _Pragma("unroll") for (int n = 0; n < 2; ++n) _Pragma("unroll") for (int k = 0; k < 2; ++k) \
        acc[ai][bj][m][n] = __builtin_amdgcn_mfma_f32_16x16x32_bf16(Bt[n][k], At[m][k], acc[ai][bj][m][n], 0, 0, 0); __builtin_amdgcn_s_setprio(0); } while (0)
#define PG8_WAIT_V(n) asm volatile("s_waitcnt vmcnt(" #n ")" ::: "memory")
#define PG8_WAIT_L(n) asm volatile("s_waitcnt lgkmcnt(" #n ")" ::: "memory")
#define PG8_BAR __builtin_amdgcn_s_barrier()
#define PG8_SCHED __builtin_amdgcn_sched_barrier(0)
    Unit cur, nxt; int ui = 0;
    if (!S.next(0, cur)) return;
    f32x4 acc[2][2][4][2];
#pragma unroll
    for (int a = 0; a < 2; ++a)
#pragma unroll
        for (int b = 0; b < 2; ++b)
#pragma unroll
            for (int m = 0; m < 4; ++m)
#pragma unroll
                for (int n = 0; n < 2; ++n) acc[a][b][m][n] = (f32x4){0.f, 0.f, 0.f, 0.f};
    bf16x8 At[4][2], B0[2][2], B1[2][2];
    const char* cA = (const char*)g.A + (size_t)cur.pm * tstep; const char* cB = (const char*)g.Bt + (size_t)cur.pn * tstep;
    S.a_ready(cur);
    if constexpr (SP2) {
        PG8_STAGE(PG8_SB(0, 0), cB, voffB); PG8_STAGE(PG8_SB(0, 1), cB + hstep, voffB); PG8_STAGE(PG8_SA(0, 0), cA, voffA); PG8_STAGE(PG8_SA(0, 1), cA + hstep, voffA);
        if (wr == 1) PG8_BAR;
        PG8_WAIT_V(2); PG8_BAR;
        PG8_STAGE(PG8_SB(1, 0), cB + kstep, voffB); PG8_STAGE(PG8_SA(1, 0), cA + kstep, voffA); PG8_STAGE(PG8_SB(1, 1), cB + hstep + kstep, voffB);
        PG8_WAIT_V(6); PG8_BAR;
    } else {
        PG8_STAGE(PG8_SB(0, 0), cB, voffB); PG8_STAGE(PG8_SA(0, 0), cA, voffA); PG8_STAGE(PG8_SB(0, 1), cB + hstep, voffB); PG8_STAGE(PG8_SA(0, 1), cA + hstep, voffA);
        if (wr == 1) PG8_BAR;
        PG8_WAIT_V(4); PG8_BAR;
        PG8_STAGE(PG8_SB(1, 0), cB + kstep, voffB); PG8_STAGE(PG8_SA(1, 0), cA + kstep, voffA); PG8_STAGE(PG8_SB(1, 1), cB + hstep + kstep, voffB);
        PG8_WAIT_V(6); PG8_BAR;
    }
    for (;;) {
        const bool has_next = S.next(ui + 1, nxt);
        const char* nA = has_next ? (const char*)g.A + (size_t)nxt.pm * tstep : cA; const char* nB = has_next ? (const char*)g.Bt + (size_t)nxt.pn * tstep : cB;
        for (int t = 0; t < nt; t += 2) {
            const bool last = (t == nt - 2);
            const char* a1 = cA + (size_t)(t + 1) * kstep;
            const char* a2 = last ? nA : cA + (size_t)(t + 2) * kstep; const char* b2 = last ? nB : cB + (size_t)(t + 2) * kstep;
            const char* a3 = a2 + kstep; const char* b3 = b2 + kstep;
            if (last && has_next) S.a_ready(nxt);
            if constexpr (SP2) {
            PG8_LDB(B0, 0, 0); PG8_LDB(B1, 0, 1); PG8_SCHED; PG8_LDA(At, 0, 0); PG8_STAGE(PG8_SA(1, 1), a1 + hstep, voffA);
            PG8_WAIT_V(8); PG8_WAIT_L(0); PG8_BAR; PG8_MMA(0, 0, At, B0); PG8_MMA(0, 1, At, B1); PG8_BAR; PG8_SCHED;
            PG8_LDA(At, 0, 1); PG8_STAGE(PG8_SB(0, 0), b2, voffB); PG8_STAGE(PG8_SB(0, 1), b2 + hstep, voffB); PG8_STAGE(PG8_SA(0, 0), a2, voffA);
            PG8_WAIT_V(8); PG8_WAIT_L(0); PG8_BAR; PG8_MMA(1, 0, At, B0); PG8_MMA(1, 1, At, B1); PG8_BAR; PG8_SCHED;
            PG8_LDB(B0, 1, 0); PG8_LDB(B1, 1, 1); PG8_SCHED; PG8_LDA(At, 1, 0); PG8_STAGE(PG8_SA(0, 1), a2 + hstep, voffA);
            PG8_WAIT_V(8); PG8_WAIT_L(0); PG8_BAR; PG8_MMA(0, 0, At, B0); PG8_MMA(0, 1, At, B1); PG8_BAR; PG8_SCHED;
            PG8_LDA(At, 1, 1); PG8_STAGE(PG8_SB(1, 0), b3, voffB); PG8_STAGE(PG8_SB(1, 1), b3 + hstep, voffB); PG8_STAGE(PG8_SA(1, 0), a3, voffA);
            PG8_WAIT_V(8); PG8_WAIT_L(0); PG8_BAR; PG8_MMA(1, 0, At, B0); PG8_MMA(1, 1, At, B1); PG8_BAR; PG8_SCHED;
            } else {
            PG8_LDB(B0, 0, 0); PG8_SCHED; PG8_LDA(At, 0, 0); PG8_STAGE(PG8_SA(1, 1), a1 + hstep, voffA);
            PG8_WAIT_L(8); PG8_BAR; PG8_WAIT_L(0); PG8_MMA(0, 0, At, B0); PG8_BAR; PG8_SCHED;
            PG8_LDB(B1, 0, 1); PG8_STAGE(PG8_SB(0, 0), b2, voffB);
            PG8_BAR; PG8_WAIT_L(0); PG8_MMA(0, 1, At, B1); PG8_BAR;
            PG8_LDA(At, 0, 1); PG8_STAGE(PG8_SA(0, 0), a2, voffA);
            PG8_BAR; PG8_WAIT_L(0); PG8_MMA(1, 0, At, B0); PG8_BAR; PG8_SCHED;
            PG8_STAGE(PG8_SB(0, 1), b2 + hstep, voffB);
            PG8_WAIT_V(6); PG8_BAR; PG8_MMA(1, 1, At, B1); PG8_BAR;
            PG8_LDB(B0, 1, 0); PG8_SCHED; PG8_LDA(At, 1, 0); PG8_STAGE(PG8_SA(0, 1), a2 + hstep, voffA);
            PG8_WAIT_L(8); PG8_BAR; PG8_WAIT_L(0); PG8_MMA(0, 0, At, B0); PG8_BAR; PG8_SCHED;
            PG8_LDB(B1, 1, 1); PG8_STAGE(PG8_SB(1, 0), b3, voffB);
            PG8_BAR; PG8_WAIT_L(0); PG8_MMA(0, 1, At, B1); PG8_BAR;
            PG8_LDA(At, 1, 1); PG8_STAGE(PG8_SA(1, 0), a3, voffA);
            PG8_BAR; PG8_WAIT_L(0); PG8_MMA(1, 0, At, B0); PG8_BAR; PG8_SCHED;
            PG8_STAGE(PG8_SB(1, 1), b3 + hstep, voffB);
            PG8_WAIT_V(6); PG8_BAR; PG8_MMA(1, 1, At, B1); PG8_BAR;
            }
        }
        if constexpr (ALIGN_EPI) { if (wr == 0) PG8_BAR; }
        if constexpr (!Epi::AFTER_DRAIN) { E(acc, cur, wr, wc, fr, fq); S.done(cur); }
        if (!has_next) break;
#pragma unroll
        for (int a = 0; a < 2; ++a)
#pragma unroll
            for (int b = 0; b < 2; ++b)
#pragma unroll
                for (int m = 0; m < 4; ++m)
#pragma unroll
                    for (int n = 0; n < 2; ++n) acc[a][b][m][n] = (f32x4){0.f, 0.f, 0.f, 0.f};
        cur = nxt; cA = nA; cB = nB; ++ui;
        if constexpr (ALIGN_EPI) { if (wr == 1) PG8_BAR; }
    }
    PG8_WAIT_V(0);
    if constexpr (!ALIGN_EPI) { if (wr == 0) PG8_BAR; }
    PG8_BAR;
    if constexpr (Epi::AFTER_DRAIN) { E.fused(acc, cur, wr, wc, fr, fq, lds, wid, lane); S.done(cur); }
#undef PG8_SA
#undef PG8_SB
#undef PG8_STAGE
#undef PG8_LDA
#undef PG8_LDB
#undef PG8_MMA
#undef PG8_WAIT_V
#undef PG8_WAIT_L
#undef PG8_BAR
#undef PG8_SCHED
}
}

__device__ __forceinline__ void transpose_tile(const float* src, int ldw, int k0, int sc0, bf16_t* dst, int dstK, int n0, const float* kscale, LAS float* tile) {
    const int tid = threadIdx.x;
#pragma unroll
    for (int i = 0; i < 8; ++i) { const int k = i * 8 + (tid >> 6), n = tid & 63; float v = src[(size_t)(k0 + k) * ldw + sc0 + n]; if (kscale) v *= kscale[k0 + k]; tile[k * 65 + n] = v; }
    __syncthreads();
    { const int n = tid >> 3, kc = tid & 7; const LAS float* s = tile + (kc * 8) * 65 + n;
      u32x4 o; o.x = pk2(s[0], s[65]); o.y = pk2(s[2 * 65], s[3 * 65]); o.z = pk2(s[4 * 65], s[5 * 65]); o.w = pk2(s[6 * 65], s[7 * 65]);
      *(u32x4*)(dst + (size_t)(n0 + n) * dstK + k0 + kc * 8) = o; }
    __syncthreads();
}
__device__ __forceinline__ void p0_phase(AP a, LAS unsigned char* lds) {
    LAS float* tile = (LAS float*)lds;
    constexpr int I_IN = 16 * 80, I_OUT = 32 * 16, I_GLU = 8 * 8, I_L = I_IN + I_OUT + I_GLU;
    for (int it = blockIdx.x; it < DEPTH * I_L; it += gridDim.x) {
        const int l = it / I_L; int r = it % I_L;
        if (r < I_IN) { const int kb = r / 80, nb = r % 80, n0 = nb * 64;
            transpose_tile(a->in[9] + (size_t)l * D * INDIM, INDIM, kb * 64, n0 + (n0 >= 3072 ? 16 : 0), (bf16_t*)(a->ws + WS_WTIN) + (size_t)l * NPROJ * D, D, n0, nullptr, tile); continue; }
        r -= I_IN;
        if (r < I_OUT) { const int kb = r / 16, nb = r % 16;
            transpose_tile(a->in[33] + (size_t)l * 2048 * D, D, kb * 64, nb * 64, (bf16_t*)(a->ws + WS_WTOUT) + (size_t)l * D * 2048, 2048, nb * 64, (kb < 16) ? (a->in[15] + l * 1024) : nullptr, tile); continue; }
        r -= I_OUT;
        { const int kb = r / 8, nb = r % 8;
            transpose_tile(a->in[31] + (size_t)l * 512 * 512, 512, kb * 64, nb * 64, (bf16_t*)(a->ws + WS_WTGLU) + (size_t)l * 512 * 512, 512, nb * 64, nullptr, tile); }
    }
}
__device__ __forceinline__ void norm_phase(AP a, int l, LAS unsigned char* lds) {
    const int tid = threadIdx.x, lane = tid & 63, w = tid >> 6;
    LAS float* Wdt = (LAS float*)lds;
    if (l < DEPTH) {
        const float* win = a->in[9] + (size_t)l * D * INDIM;
        for (int idx = tid; idx < 16 * 1024; idx += 512) { const int c = idx & 15, k = idx >> 4; Wdt[c * 1024 + k] = win[(size_t)k * INDIM + 3072 + c]; }
    }
    __syncthreads();
    const float* srcP = (l == 0) ? a->in[0] : (const float*)(a->ws + WS_XB);
    const float* srcS = (l == 0) ? a->in[1] : (const float*)(a->ws + WS_XB) + (size_t)NP * D;
    const float* g = (l < DEPTH) ? (a->in[8] + l * D) : a->in[34];
    f32x4 gv[4];
#pragma unroll
    for (int j = 0; j < 4; ++j) gv[j] = *(const f32x4*)(g + 4 * lane + 256 * j);
    bf16_t* hb = (bf16_t*)(a->ws + WS_HB); float* dtraw = (float*)(a->ws + WS_DTRAW);
    for (int row = blockIdx.x * 8 + w; row < MT; row += gridDim.x * 8) {
        const float* xr = (row < NP) ? (srcP + (size_t)row * D) : (srcS + (size_t)(row - NP) * D);
        f32x4 v[4]; float s = 0.f;
#pragma unroll
        for (int j = 0; j < 4; ++j) { v[j] = *(const f32x4*)(xr + 4 * lane + 256 * j); s += (v[j].x * v[j].x + v[j].y * v[j].y) + (v[j].z * v[j].z + v[j].w * v[j].w); }
        const float rs = rsqrtf(wave_sum(s) * (1.f / D) + EPS);
#pragma unroll
        for (int j = 0; j < 4; ++j) v[j] = v[j] * rs * gv[j];
        if (l < DEPTH) {
#pragma unroll
            for (int j = 0; j < 4; ++j) { u32x2 o; o.x = pk2(v[j].x, v[j].y); o.y = pk2(v[j].z, v[j].w); *(u32x2*)(hb + (size_t)row * D + 4 * lane + 256 * j) = o; }
            float mine = 0.f;
#pragma unroll 1
            for (int c = 0; c < 16; ++c) { float d = 0.f;
#pragma unroll
                for (int j = 0; j < 4; ++j) { const f32x4 wv = *(const LAS f32x4*)(Wdt + c * 1024 + 4 * lane + 256 * j); d += (v[j].x * wv.x + v[j].y * wv.y) + (v[j].z * wv.z + v[j].w * wv.w); }
                d = wave_sum(d); if (lane == c) mine = d; }
            if (lane < 16) dtraw[(size_t)row * 16 + lane] = mine;
        } else {
#pragma unroll
            for (int j = 0; j < 4; ++j) *(f32x4*)(a->out + O_YP + (size_t)row * D + 4 * lane + 256 * j) = v[j];
        }
    }
    __syncthreads();
}
__device__ __forceinline__ void ssdnorm_rows(AP a) {
    const int tid = threadIdx.x, lane = tid & 63, w = tid >> 6;
    bf16_t* A2 = (bf16_t*)(a->ws + WS_A2); const float* ssq = (const float*)(a->ws + WS_SSQ);
    for (int row = blockIdx.x * 8 + w; row < MT; row += gridDim.x * 8) {
        float s = (lane < 16) ? ssq[(size_t)row * 16 + lane] : 0.f;
        const float rs = rsqrtf(wave_sum(s) * (1.f / 1024.f) + EPS);
#pragma unroll
        for (int j = 0; j < 2; ++j) { u32x4* p = (u32x4*)(A2 + (size_t)row * 2048 + 8 * lane + 512 * j); u32x4 v = *p;
            v.x = pk2(lo16(v.x) * rs, hi16(v.x) * rs); v.y = pk2(lo16(v.y) * rs, hi16(v.y) * rs); v.z = pk2(lo16(v.z) * rs, hi16(v.z) * rs); v.w = pk2(lo16(v.w) * rs, hi16(v.w) * rs); *p = v; }
    }
}

constexpr int SSD_TT = 32;
__device__ __forceinline__ void ssd_unit(AP a, int l, int sq, int hd, LAS unsigned char* lds) {
    asm volatile("" : "+s"(a));
    const int tid = threadIdx.x;
    const bool isS = sq >= BATCH; const int b = isS ? sq - BATCH : sq, L = isS ? DSEQ : SEQ, nb = isS ? DBATCH : BATCH;
    const int row0 = isS ? NP + b * DSEQ : b * SEQ, g = hd >> 2;
    LAS float* raw = (LAS float*)lds;
    LAS float* xs = raw + (SSD_TT + 3) * 320;
    LAS float* Bs = xs + SSD_TT * 64;
    LAS float* Cs = Bs + SSD_TT * 128;
    LAS float* ys = Cs + SSD_TT * 128;
    LAS float* dts = ys + SSD_TT * 64;
    LAS float* dAs = dts + SSD_TT;
    const bf16_t* proj = (const bf16_t*)(a->ws + WS_PROJ); const float* dtraw = (const float*)(a->ws + WS_DTRAW);
    bf16_t* A2 = (bf16_t*)(a->ws + WS_A2); float* ssq = (float*)(a->ws + WS_SSQ);
    const float* cw = a->in[10] + (size_t)l * 4 * 2048; const float* cb = a->in[11] + l * 2048;
    const float dtb = a->in[12][l * 16 + hd], aneg = -__expf(a->in[13][l * 16 + hd]), Dh = a->in[14][l * 16 + hd];
    const float* cst = a->in[3] + (size_t)(l * DBATCH + b) * 3 * 2048;
    const int p = tid >> 3, nq = tid & 7;
    float h[16];
    if (isS) { const f32x4* s = (const f32x4*)(a->in[2] + ((((size_t)l * DBATCH + b) * 16 + hd) * 64 + p) * 128 + nq * 16);
#pragma unroll
        for (int j = 0; j < 4; ++j) { const f32x4 v = s[j]; h[4 * j] = v.x; h[4 * j + 1] = v.y; h[4 * j + 2] = v.z; h[4 * j + 3] = v.w; } }
    else {
#pragma unroll
        for (int j = 0; j < 16; ++j) h[j] = 0.f; }
    for (int t0 = 0; t0 < L; t0 += SSD_TT) {
        const int nt = (L - t0 < SSD_TT) ? (L - t0) : SSD_TT;
        for (int idx = tid; idx < (nt + 3) * 320; idx += 512) { const int rr = idx / 320, cc = idx - rr * 320, tt = t0 - 3 + rr;
            const int cconv = cc < 64 ? hd * 64 + cc : (cc < 192 ? 1024 + g * 128 + (cc - 64) : 1536 + g * 128 + (cc - 192));
            float v;
            if (tt >= 0) v = bf2f(proj[(size_t)(row0 + tt) * NPROJ + PC_X + cconv]); else v = isS ? cst[(3 + tt) * 2048 + cconv] : 0.f;
            raw[idx] = v; }
        if (tid < nt) { const float dt = softplus_f(dtraw[(size_t)(row0 + t0 + tid) * 16 + hd] + dtb); dts[tid] = dt; dAs[tid] = __expf(dt * aneg); }
        __syncthreads();
        for (int idx = tid; idx < nt * 320; idx += 512) { const int t = idx / 320, cc = idx - t * 320;
            const int cconv = cc < 64 ? hd * 64 + cc : (cc < 192 ? 1024 + g * 128 + (cc - 64) : 1536 + g * 128 + (cc - 192));
            float acc = cb[cconv];
#pragma unroll
            for (int k = 0; k < 4; ++k) acc += cw[k * 2048 + cconv] * raw[(t + k) * 320 + cc];
            acc = silu_f(acc);
            if (cc < 64) xs[t * 64 + cc] = acc; else if (cc < 192) Bs[t * 128 + cc - 64] = acc; else Cs[t * 128 + cc - 192] = acc; }
        __syncthreads();
        for (int t = 0; t < nt; ++t) {
            const float dA = dAs[t], dtx = dts[t] * xs[t * 64 + p]; float acc = 0.f;
            const LAS f32x4* B4 = (const LAS f32x4*)(Bs + t * 128 + nq * 16); const LAS f32x4* C4 = (const LAS f32x4*)(Cs + t * 128 + nq * 16);
#pragma unroll
            for (int j = 0; j < 4; ++j) { const f32x4 bv = B4[j], cv = C4[j];
                h[4 * j] = dA * h[4 * j] + dtx * bv.x; acc += cv.x * h[4 * j];
                h[4 * j + 1] = dA * h[4 * j + 1] + dtx * bv.y; acc += cv.y * h[4 * j + 1];
                h[4 * j + 2] = dA * h[4 * j + 2] + dtx * bv.z; acc += cv.z * h[4 * j + 2];
                h[4 * j + 3] = dA * h[4 * j + 3] + dtx * bv.w; acc += cv.w * h[4 * j + 3]; }
            acc += __shfl_xor(acc, 1); acc += __shfl_xor(acc, 2); acc += __shfl_xor(acc, 4);
            if (nq == 0) ys[t * 64 + p] = acc;
        }
        __syncthreads();
        { const int t = tid >> 4, p4 = (tid & 15) * 4; float s2 = 0.f; const size_t row = (size_t)(row0 + t0 + t);
          if (t < nt) { const u32x2 zz = *(const u32x2*)(proj + row * NPROJ + PC_Z + hd * 64 + p4);
              const float z0 = lo16(zz.x), z1 = hi16(zz.x), z2 = lo16(zz.y), z3 = hi16(zz.y);
              const float u0 = (ys[t * 64 + p4] + Dh * xs[t * 64 + p4]) * silu_f(z0), u1 = (ys[t * 64 + p4 + 1] + Dh * xs[t * 64 + p4 + 1]) * silu_f(z1);
              const float u2 = (ys[t * 64 + p4 + 2] + Dh * xs[t * 64 + p4 + 2]) * silu_f(z2), u3 = (ys[t * 64 + p4 + 3] + Dh * xs[t * 64 + p4 + 3]) * silu_f(z3);
              s2 = (u0 * u0 + u1 * u1) + (u2 * u2 + u3 * u3);
              u32x2 o; o.x = pk2(u0, u1); o.y = pk2(u2, u3); *(u32x2*)(A2 + row * 2048 + hd * 64 + p4) = o; }
          s2 += __shfl_xor(s2, 1); s2 += __shfl_xor(s2, 2); s2 += __shfl_xor(s2, 4); s2 += __shfl_xor(s2, 8);
          if ((tid & 15) == 0 && t < nt) ssq[row * 16 + hd] = s2; }
        __syncthreads();
    }
    { f32x4* o = (f32x4*)(a->out + (isS ? O_SSDS : O_SSDP) + ((((size_t)l * nb + b) * 16 + hd) * 64 + p) * 128 + nq * 16);
#pragma unroll
      for (int j = 0; j < 4; ++j) { f32x4 v; v.x = h[4 * j]; v.y = h[4 * j + 1]; v.z = h[4 * j + 2]; v.w = h[4 * j + 3]; o[j] = v; } }
    { float* co = a->out + (isS ? O_SCS : O_SCP) + ((size_t)l * nb + b) * 3 * 2048;
      if (tid < 192) { const int j = tid >> 6, cc = tid & 63; co[j * 2048 + hd * 64 + cc] = bf2f(proj[(size_t)(row0 + L - 3 + j) * NPROJ + PC_X + hd * 64 + cc]); }
      if ((hd & 3) == 0) for (int idx = tid; idx < 3 * 256; idx += 512) { const int j = idx >> 8, cc = idx & 255; const int cconv = cc < 128 ? 1024 + g * 128 + cc : 1536 + g * 128 + (cc - 128);
          co[j * 2048 + cconv] = bf2f(proj[(size_t)(row0 + L - 3 + j) * NPROJ + PC_X + cconv]); } }
}

__device__ __forceinline__ void lru_unit(AP a, int l, bool isS, int bq, int k, LAS unsigned char* lds) {
    asm volatile("" : "+s"(a));
    const int tid = threadIdx.x, j = tid & 63, w = tid >> 6, ch = k * 64 + j;
    LAS float* xrT = (LAS float*)lds;
    LAS float* was = xrT + 4096;
    LAS float* wxs = was + 4096;
    LAS float* cA = wxs + 4096;
    LAS float* cH = cA + 512;
    const bf16_t* proj = (const bf16_t*)(a->ws + WS_PROJ); bf16_t* A2 = (bf16_t*)(a->ws + WS_A2);
    { const float* wa = a->in[18] + (size_t)(l * 8 + k) * 4096; const float* wx = a->in[20] + (size_t)(l * 8 + k) * 4096;
      for (int idx = tid; idx < 4096; idx += 512) { was[idx] = wa[idx]; wxs[idx] = wx[idx]; } }
    const float ba = a->in[19][l * 512 + ch], bx = a->in[21][l * 512 + ch], sp = softplus_f(-a->in[22][l * 512 + ch]);
    const float cw0 = a->in[16][(l * 4 + 0) * 512 + ch], cw1 = a->in[16][(l * 4 + 1) * 512 + ch], cw2 = a->in[16][(l * 4 + 2) * 512 + ch], cw3 = a->in[16][(l * 4 + 3) * 512 + ch], cbias = a->in[17][l * 512 + ch];
    const int bseq = isS ? bq * 8 + w : bq, nb = isS ? DBATCH : BATCH, L = isS ? DSEQ : SEQ;
    const int rowseq = isS ? NP + bseq * DSEQ : bseq * SEQ;
    float H = isS ? a->in[4][(size_t)(l * DBATCH + bseq) * 512 + ch] : 0.f;
    const float* cst = a->in[5] + (size_t)(l * DBATCH + bseq) * 3 * 512;
    const int ntile = isS ? 1 : SEQ / 64;
    for (int ti = 0; ti < ntile; ++ti) {
        const int ti0 = isS ? 0 : ti * 64 + w * 8;
        const size_t rw = (size_t)(rowseq + ti0);
        float v[11];
#pragma unroll
        for (int i = 0; i < 11; ++i) { const int tk = ti0 - 3 + i;
            v[i] = (tk >= 0) ? bf2f(proj[(rw - 3 + i) * NPROJ + PC_LX + ch]) : (isS ? cst[(3 + tk) * 512 + ch] : 0.f); }
        float xr[8];
#pragma unroll
        for (int tl = 0; tl < 8; ++tl) { xr[tl] = cbias + cw0 * v[tl] + cw1 * v[tl + 1] + cw2 * v[tl + 2] + cw3 * v[tl + 3]; }
        { f32x4 x0, x1; x0.x = xr[0]; x0.y = xr[1]; x0.z = xr[2]; x0.w = xr[3]; x1.x = xr[4]; x1.y = xr[5]; x1.z = xr[6]; x1.w = xr[7];
          *(LAS f32x4*)(xrT + j * 64 + w * 8) = x0; *(LAS f32x4*)(xrT + j * 64 + w * 8 + 4) = x1; }
        __syncthreads();
        float ra[8], rx[8];
#pragma unroll
        for (int tl = 0; tl < 8; ++tl) { ra[tl] = ba; rx[tl] = bx; }
        for (int i = 0; i < 64; ++i) { const float wa_ = was[i * 64 + j], wx_ = wxs[i * 64 + j];
            const f32x4 x0 = *(const LAS f32x4*)(xrT + i * 64 + w * 8), x1 = *(const LAS f32x4*)(xrT + i * 64 + w * 8 + 4);
            ra[0] += x0.x * wa_; ra[1] += x0.y * wa_; ra[2] += x0.z * wa_; ra[3] += x0.w * wa_; ra[4] += x1.x * wa_; ra[5] += x1.y * wa_; ra[6] += x1.z * wa_; ra[7] += x1.w * wa_;
            rx[0] += x0.x * wx_; rx[1] += x0.y * wx_; rx[2] += x0.z * wx_; rx[3] += x0.w * wx_; rx[4] += x1.x * wx_; rx[5] += x1.y * wx_; rx[6] += x1.z * wx_; rx[7] += x1.w * wx_; }
        float hl[8], Ap[8]; float hh = 0.f, aa = 1.f;
#pragma unroll
        for (int tl = 0; tl < 8; ++tl) { const float r = sigmoid_f(ra[tl]), gi = sigmoid_f(rx[tl]); const float la = -8.f * r * sp; const float at = __expf(la);
            const float gain = sqrtf(fmaxf(-expm1f(2.f * la), 0.f)); const float bt = gain * gi * xr[tl];
            hh = at * hh + bt; aa *= at; hl[tl] = hh; Ap[tl] = aa; }
        float Hw = H, Hend;
        if (!isS) {
            cA[w * 64 + j] = aa; cH[w * 64 + j] = hh;
            __syncthreads();
            float Hin = H;
#pragma unroll
            for (int w2 = 0; w2 < 8; ++w2) { if (w2 == w) Hw = Hin; Hin = cA[w2 * 64 + j] * Hin + cH[w2 * 64 + j]; }
            Hend = Hin;
        } else Hend = hl[7] + Ap[7] * H;
#pragma unroll
        for (int tl = 0; tl < 8; ++tl) { const float hv = hl[tl] + Ap[tl] * Hw; const float gt = bf2f(proj[(rw + tl) * NPROJ + PC_LG + ch]);
            A2[(rw + tl) * 2048 + 1024 + ch] = f2bf(hv * silu_f(gt)); }
        H = Hend;
        __syncthreads();
    }
    if (isS || w == 0) a->out[(isS ? O_LRUS : O_LRUP) + (size_t)(l * nb + bseq) * 512 + ch] = H;
    if (isS || w == 0) { float* co = a->out + (isS ? O_LCS : O_LCP) + (size_t)(l * nb + bseq) * 3 * 512;
#pragma unroll
        for (int jj = 0; jj < 3; ++jj) co[jj * 512 + ch] = bf2f(proj[(size_t)(rowseq + L - 3 + jj) * NPROJ + PC_LX + ch]); }
}

__device__ __forceinline__ void s5_unit(AP a, int l, bool isS, int bq, int g, LAS unsigned char* lds) {
    asm volatile("" : "+s"(a));
    const int tid = threadIdx.x, p = tid & 63, w = tid >> 6;
    LAS float* us = (LAS float*)lds;
    LAS float* hrs = us + 1024;
    LAS float* his = hrs + 4096;
    LAS float* cre = his + 4096;
    LAS float* cim = cre + 16 * 68;
    LAS float* cE = cim + 16 * 68;
    const bf16_t* proj = (const bf16_t*)(a->ws + WS_PROJ); bf16_t* G5 = (bf16_t*)(a->ws + WS_G5);
    const int lg = l * 32 + g;
    float ar, ai; float Bre[16], Bim[16];
    { const float delta = __expf(a->in[25][lg]); const float lr = a->in[23][(size_t)lg * 64 + p], li = a->in[24][(size_t)lg * 64 + p];
      const float mag = expf(lr * delta), ang = li * delta; ar = mag * cosf(ang); ai = mag * sinf(ang);
      const float den = lr * lr + li * li, nr = ar - 1.f, ni = ai; const float cr = (nr * lr + ni * li) / den, ci = (ni * lr - nr * li) / den;
      const f32x4* br = (const f32x4*)(a->in[26] + ((size_t)lg * 64 + p) * 16); const f32x4* bi = (const f32x4*)(a->in[27] + ((size_t)lg * 64 + p) * 16);
#pragma unroll
      for (int q = 0; q < 4; ++q) { const f32x4 r4 = br[q], i4 = bi[q];
          Bre[4 * q] = cr * r4.x - ci * i4.x; Bim[4 * q] = cr * i4.x + ci * r4.x; Bre[4 * q + 1] = cr * r4.y - ci * i4.y; Bim[4 * q + 1] = cr * i4.y + ci * r4.y;
          Bre[4 * q + 2] = cr * r4.z - ci * i4.z; Bim[4 * q + 2] = cr * i4.z + ci * r4.z; Bre[4 * q + 3] = cr * r4.w - ci * i4.w; Bim[4 * q + 3] = cr * i4.w + ci * r4.w; } }
    float pr[8], pi[8]; pr[0] = ar; pi[0] = ai;
#pragma unroll
    for (int q = 1; q < 8; ++q) { pr[q] = pr[q - 1] * ar - pi[q - 1] * ai; pi[q] = pr[q - 1] * ai + pi[q - 1] * ar; }
    for (int idx = tid; idx < 1024; idx += 512) { const int h = idx >> 6, pp = idx & 63; cre[h * 68 + pp] = a->in[28][(size_t)lg * 1024 + idx]; cim[h * 68 + pp] = a->in[29][(size_t)lg * 1024 + idx]; }
    const int bseq = isS ? bq * 8 + w : bq, nb = isS ? DBATCH : BATCH;
    float Hr = 0.f, Hi = 0.f;
    if (isS) { Hr = a->in[6][((size_t)(l * DBATCH + bseq) * 32 + g) * 64 + p]; Hi = a->in[7][((size_t)(l * DBATCH + bseq) * 32 + g) * 64 + p]; }
    const int ntile = isS ? 1 : SEQ / 64;
    const float dh0 = a->in[30][l * 512 + g * 16 + (tid & 15)];
    for (int ti = 0; ti < ntile; ++ti) {
        const size_t rbase = isS ? (size_t)(NP + bq * 64) : (size_t)(bq * SEQ + ti * 64);
        for (int idx = tid; idx < 1024; idx += 512) us[idx] = bf2f(proj[(rbase + (idx >> 4)) * NPROJ + PC_SU + g * 16 + (idx & 15)]);
        __syncthreads();
        float hlr[8], hli[8]; float hr = 0.f, hi = 0.f;
#pragma unroll
        for (int tl = 0; tl < 8; ++tl) { const LAS f32x4* u4 = (const LAS f32x4*)(us + (w * 8 + tl) * 16); float br_ = 0.f, bi_ = 0.f;
#pragma unroll
            for (int q = 0; q < 4; ++q) { const f32x4 uv = u4[q];
                br_ += uv.x * Bre[4 * q] + uv.y * Bre[4 * q + 1] + uv.z * Bre[4 * q + 2] + uv.w * Bre[4 * q + 3];
                bi_ += uv.x * Bim[4 * q] + uv.y * Bim[4 * q + 1] + uv.z * Bim[4 * q + 2] + uv.w * Bim[4 * q + 3]; }
            const float nr_ = ar * hr - ai * hi + br_, ni_ = ar * hi + ai * hr + bi_; hr = nr_; hi = ni_; hlr[tl] = hr; hli[tl] = hi; }
        float Hwr = Hr, Hwi = Hi, Her, Hei;
        if (!isS) {
            cE[(w * 64 + p) * 2] = hr; cE[(w * 64 + p) * 2 + 1] = hi;
            __syncthreads();
            float Hinr = Hr, Hini = Hi;
#pragma unroll
            for (int w2 = 0; w2 < 8; ++w2) { if (w2 == w) { Hwr = Hinr; Hwi = Hini; }
                const float er = cE[(w2 * 64 + p) * 2], ei = cE[(w2 * 64 + p) * 2 + 1];
                const float tr = pr[7] * Hinr - pi[7] * Hini + er, tq = pr[7] * Hini + pi[7] * Hinr + ei; Hinr = tr; Hini = tq; }
            Her = Hinr; Hei = Hini;
        } else { Her = hlr[7] + pr[7] * Hr - pi[7] * Hi; Hei = hli[7] + pr[7] * Hi + pi[7] * Hr; }
#pragma unroll
        for (int tl = 0; tl < 8; ++tl) { hrs[(w * 8 + tl) * 64 + p] = hlr[tl] + pr[tl] * Hwr - pi[tl] * Hwi; his[(w * 8 + tl) * 64 + p] = hli[tl] + pr[tl] * Hwi + pi[tl] * Hwr; }
        Hr = Her; Hi = Hei;
        __syncthreads();
        { const int h = tid & 15;
#pragma unroll
          for (int half = 0; half < 2; ++half) { const int t = (tid >> 4) + 32 * half; float acc = 0.f;
              const LAS f32x4* r4 = (const LAS f32x4*)(hrs + t * 64); const LAS f32x4* i4 = (const LAS f32x4*)(his + t * 64);
              const LAS f32x4* c4 = (const LAS f32x4*)(cre + h * 68); const LAS f32x4* d4 = (const LAS f32x4*)(cim + h * 68);
#pragma unroll 4
              for (int q = 0; q < 16; ++q) { const f32x4 rv = r4[q], iv = i4[q], cv = c4[q], dv = d4[q];
                  acc += (rv.x * cv.x + rv.y * cv.y) + (rv.z * cv.z + rv.w * cv.w) - ((iv.x * dv.x + iv.y * dv.y) + (iv.z * dv.z + iv.w * dv.w)); }
              const float y = acc + dh0 * us[t * 16 + h];
              G5[(rbase + t) * 512 + g * 16 + h] = f2bf(gelu_f(y)); } }
        __syncthreads();
    }
    if (isS || w == 0) { a->out[(isS ? O_S5RS : O_S5RP) + ((size_t)(l * nb + bseq) * 32 + g) * 64 + p] = Hr; a->out[(isS ? O_S5IS : O_S5IP) + ((size_t)(l * nb + bseq) * 32 + g) * 64 + p] = Hi; }
}

constexpr int U_SSDP = 0, U_S5P = U_SSDP + BATCH * 16, U_LRUP = U_S5P + BATCH * 32, U_SSDS = U_LRUP + BATCH * 8, U_S5S = U_SSDS + DBATCH * 16, U_LRUS = U_S5S + (DBATCH / 8) * 32, U_END = U_LRUS + (DBATCH / 8) * 8;
__device__ __forceinline__ void mixer_phase(AP am, int l, LAS unsigned char* lds) {
    unsigned* ctr = (unsigned*)(am->ws + WS_CTR) + l * 64;
    LAS unsigned* slot = (LAS unsigned*)(lds + LDS_BYTES - 16);
    for (;;) {
        if (threadIdx.x == 0) *slot = atomicAdd(ctr, 1u);
        __syncthreads();
        const int u = (int)*slot;
        __syncthreads();
        if (u >= U_END) break;
        AP a = am; asm volatile("" : "+s"(a));
        if (u < U_S5P) ssd_unit(a, l, u >> 4, u & 15, lds);
        else if (u < U_LRUP) s5_unit(a, l, false, (u - U_S5P) >> 5, (u - U_S5P) & 31, lds);
        else if (u < U_SSDS) lru_unit(a, l, false, (u - U_LRUP) >> 3, (u - U_LRUP) & 7, lds);
        else if (u < U_S5S) ssd_unit(a, l, BATCH + ((u - U_SSDS) >> 4), (u - U_SSDS) & 15, lds);
        else if (u < U_LRUS) s5_unit(a, l, true, (u - U_S5S) >> 5, (u - U_S5S) & 31, lds);
        else lru_unit(a, l, true, (u - U_LRUS) >> 3, (u - U_LRUS) & 7, lds);
        __syncthreads();
    }
}

template <int KIND> __global__ void __launch_bounds__(512, 2) k_phase(Args a_) {
    extern __shared__ __attribute__((aligned(16))) unsigned char smem[];
    LAS unsigned char* lds = (LAS unsigned char*)smem;
    AP a = (AP)__builtin_amdgcn_kernarg_segment_ptr();
    const int l = a->ph_lo;
    if constexpr (KIND == 0) { p0_phase(a, lds); norm_phase(a, 0, lds); }
    if constexpr (KIND == 1) {
        pg8::Gemm g{(const bf16_t*)(a->ws + WS_HB), (const bf16_t*)(a->ws + WS_WTIN) + (size_t)l * NPROJ * D, MT, NPROJ, D};
        pg8::StaticOrder S; S.init(MT, NPROJ, (int)gridDim.x, (int)blockIdx.x);
        pg8::EpiProj E{(bf16_t*)(a->ws + WS_PROJ), NPROJ};
        pg8::gemm_phase<pg8::EpiProj, pg8::StaticOrder, true, true>(lds, g, S, E);
    }
    if constexpr (KIND == 2) mixer_phase(a, l, lds);
    if constexpr (KIND == 3) {
        pg8::Gemm g{(const bf16_t*)(a->ws + WS_G5), (const bf16_t*)(a->ws + WS_WTGLU) + (size_t)l * 512 * 512, MT, 512, 512};
        pg8::StaticOrder S; S.init(MT, 512, (int)gridDim.x, (int)blockIdx.x);
        pg8::EpiGlu E{(const bf16_t*)(a->ws + WS_G5), (const bf16_t*)(a->ws + WS_PROJ), (bf16_t*)(a->ws + WS_A2), a->in[32] + l * 512};
        pg8::gemm_phase<pg8::EpiGlu, pg8::StaticOrder, true, true>(lds, g, S, E);
        ssdnorm_rows(a);
    }
    if constexpr (KIND == 4) {
        pg8::Gemm g{(const bf16_t*)(a->ws + WS_A2), (const bf16_t*)(a->ws + WS_WTOUT) + (size_t)l * D * 2048, MT, D, 2048};
        pg8::StaticOrder S; S.init(MT, D, (int)gridDim.x, (int)blockIdx.x);
        pg8::EpiRes E{l == 0 ? a->in[0] : (const float*)(a->ws + WS_XB), l == 0 ? a->in[1] : (const float*)(a->ws + WS_XB) + (size_t)NP * D, (float*)(a->ws + WS_XB)};
        pg8::gemm_phase<pg8::EpiRes, pg8::StaticOrder, true, true>(lds, g, S, E);
    }
    if constexpr (KIND == 5) norm_phase(a, l + 1, lds);
}
template <int KIND> static void launch_phase(Args& a, int l, int grid, hipStream_t stream) {
    static bool attr = false;
    if (!attr) { (void)hipFuncSetAttribute((const void*)k_phase<KIND>, hipFuncAttributeMaxDynamicSharedMemorySize, LDS_BYTES); attr = true; }
    a.ph_lo = l; a.ph_hi = 0;
    hipLaunchKernelGGL(k_phase<KIND>, dim3(grid), dim3(512), LDS_BYTES, stream, a);
}
extern "C" void kernel_launch(void* const* d_in, const int* in_sizes, int n_in, void* d_out, int out_size, void* d_ws, size_t ws_size, hipStream_t stream) {
    static int grid = 0;
    if (grid == 0) {
        if (n_in != 35 || (size_t)out_size != O_END || ws_size < WS_END) { fprintf(stderr, "kernel_launch: unexpected shapes n_in %d out %d ws %zu (need %zu)\n", n_in, out_size, ws_size, (size_t)WS_END); grid = -1; return; }
        int dev = 0, cus = 0;
        if (hipGetDevice(&dev) != hipSuccess || hipDeviceGetAttribute(&cus, hipDeviceAttributeMultiprocessorCount, dev) != hipSuccess) { grid = -1; return; }
        grid = cus;
    }
    if (grid < 0) return;
    (void)hipMemsetAsync((char*)d_ws + WS_CTR, 0, 4096, stream);
    Args a{};
    for (int i = 0; i < 35; ++i) a.in[i] = (const float*)d_in[i];
    a.out = (float*)d_out; a.ws = (unsigned char*)d_ws;
    launch_phase<0>(a, 0, grid, stream);
    for (int l = 0; l < DEPTH; ++l) { launch_phase<1>(a, l, grid, stream); launch_phase<2>(a, l, grid, stream); launch_phase<3>(a, l, grid, stream); launch_phase<4>(a, l, grid, stream); launch_phase<5>(a, l, grid, stream); }
}
```

```cpp
#include <hip/hip_runtime.h>
#include <hip/hip_cooperative_groups.h>
#include <cstdio>
#include <cstdint>
namespace cg = cooperative_groups;

#define LAS __attribute__((address_space(3)))
typedef unsigned short bf16_t;
typedef float f32x4 __attribute__((ext_vector_type(4)));
typedef float f32x2 __attribute__((ext_vector_type(2)));
typedef unsigned u32x4 __attribute__((ext_vector_type(4)));
typedef unsigned u32x2 __attribute__((ext_vector_type(2)));

constexpr int D = 1024, NP = 16384, NSR = 1024, MT = NP + NSR, DEPTH = 4, NPROJ = 5376, INDIM = 5136;
constexpr int SEQ = 2048, DSEQ = 8, BATCH = 8, DBATCH = 128;
constexpr float EPS = 1e-6f;
constexpr int LDA2 = 2048 + 64, LDHB = 1024 + 64;
constexpr int PC_Z = 0, PC_X = 1024, PC_B = 2048, PC_C = 2560, PC_LX = 3072, PC_LG = 3584, PC_SU = 4096, PC_SG = 4608, PC_DT = 5120;
constexpr size_t O_YP = 0, O_YS = O_YP + (size_t)NP * D, O_SSDP = O_YS + (size_t)NSR * D, O_SSDS = O_SSDP + (size_t)DEPTH * BATCH * 16 * 64 * 128,
    O_SCP = O_SSDS + (size_t)DEPTH * DBATCH * 16 * 64 * 128, O_SCS = O_SCP + (size_t)DEPTH * BATCH * 3 * 2048, O_LRUP = O_SCS + (size_t)DEPTH * DBATCH * 3 * 2048,
    O_LRUS = O_LRUP + (size_t)DEPTH * BATCH * 512, O_LCP = O_LRUS + (size_t)DEPTH * DBATCH * 512, O_LCS = O_LCP + (size_t)DEPTH * BATCH * 3 * 512,
    O_S5RP = O_LCS + (size_t)DEPTH * DBATCH * 3 * 512, O_S5RS = O_S5RP + (size_t)DEPTH * BATCH * 2048, O_S5IP = O_S5RS + (size_t)DEPTH * DBATCH * 2048,
    O_S5IS = O_S5IP + (size_t)DEPTH * BATCH * 2048, O_END = O_S5IS + (size_t)DEPTH * DBATCH * 2048;
constexpr size_t WS_CTR = 0, WS_BAR = 4096, WS_WTIN = 4096 + 16384, WS_WTOUT = WS_WTIN + (size_t)DEPTH * NPROJ * LDHB * 2, WS_WTGLU = WS_WTOUT + (size_t)DEPTH * D * LDA2 * 2,
    WS_HB = WS_WTGLU + (size_t)DEPTH * 512 * 512 * 2, WS_PROJ = WS_HB + (size_t)MT * LDHB * 2, WS_DTRAW = WS_PROJ + (size_t)MT * NPROJ * 2,
    WS_A2 = WS_DTRAW + (size_t)MT * 16 * 4, WS_G5 = WS_A2 + (size_t)MT * LDA2 * 2, WS_XB = WS_G5 + (size_t)MT * 512 * 2, WS_SSQ = WS_XB + (size_t)MT * D * 4,
    WS_XBC = WS_SSQ + (size_t)MT * 32 * 4, WS_END = WS_XBC + (size_t)MT * 2048 * 2;
constexpr int LDS_BYTES = 131072 + 64;
constexpr int NPH = 1 + 6 * DEPTH;

struct Args { const float* in[35]; float* out; unsigned char* ws; int ph_lo, ph_hi; };
#define CAS __attribute__((address_space(4)))
typedef const CAS Args* AP;

__device__ __forceinline__ float bf2f(bf16_t v) { return __uint_as_float(((unsigned)v) << 16); }
typedef __bf16 bf16x2_t __attribute__((ext_vector_type(2)));
__device__ __forceinline__ unsigned pk2(float lo, float hi) { f32x2 v = {lo, hi}; bf16x2_t r = __builtin_convertvector(v, bf16x2_t); return __builtin_bit_cast(unsigned, r); }
__device__ __forceinline__ bf16_t f2bf(float f) { return (bf16_t)(pk2(f, 0.f) & 0xffffu); }
__device__ __forceinline__ float lo16(unsigned w) { return __uint_as_float(w << 16); }
__device__ __forceinline__ float hi16(unsigned w) { return __uint_as_float(w & 0xffff0000u); }
__device__ __forceinline__ float fexp(float x) { return __builtin_amdgcn_exp2f(x * 1.4426950408889634f); }
__device__ __forceinline__ float sigmoid_f(float x) { return __builtin_amdgcn_rcpf(1.f + fexp(-x)); }
__device__ __forceinline__ float silu_f(float x) { return x * __builtin_amdgcn_rcpf(1.f + fexp(-x)); }
__device__ __forceinline__ float softplus_f(float x) { return fmaxf(x, 0.f) + 0.6931471805599453f * __builtin_amdgcn_logf(1.f + fexp(-fabsf(x))); }
__device__ __forceinline__ float gelu_f(float x) { return x * sigmoid_f(1.5957691216057308f * (x + 0.044715f * x * x * x)); }
__device__ __forceinline__ float wave_sum(float v) {
#pragma unroll
    for (int o = 1; o < 64; o <<= 1) v += __shfl_xor(v, o);
    return v;
}

namespace pg8 {
#define PG8_LAS __attribute__((address_space(3)))
typedef unsigned short bf16_t;
typedef short bf16x8 __attribute__((ext_vector_type(8)));
typedef float f32x4 __attribute__((ext_vector_type(4)));
typedef unsigned u32x4 __attribute__((ext_vector_type(4)));
constexpr int BM = 256, BK = 64, HALF = 128, HTB = HALF * BK * 2  , STAGE_BYTES = 8 * HTB, NXCD = 8, WGM = 8;

__host__ __device__ __forceinline__ int lds_byte(int r, int c) { const int st = (r >> 4) * 2 + (c >> 5), rr = r & 15, cc = c & 31, ob = rr * 64 + cc * 2; return st * 1024 + (ob ^ (((ob >> 9) & 1) << 5)); }
__host__ __device__ __forceinline__ void stage_rc(int b, int& R, int& C) { const int st = b / 1024, sb = b % 1024, swz = sb ^ (((sb >> 9) & 1) << 5); R = (st >> 1) * 16 + swz / 64; C = (st & 1) * 32 + (swz % 64) / 2; }
__host__ __device__ __forceinline__ int perm32(int rho) { const int n = rho >> 4, i = rho & 15; return 8 * (i >> 2) + 4 * n + (i & 3); }

struct Unit { int pm, pn; };
struct Gemm { const bf16_t* A; const bf16_t* Bt; int M, N, K, lda, ldb; };

struct StaticOrder {
    int nM, nN, nwg, G, c;
    __host__ __device__ void init(int M, int N, int G_, int c_) { nM = M / BM; nN = N / BM; nwg = nM * nN; G = G_; c = c_; }
    __host__ __device__ bool next(int i, Unit& u) const {
        const long L = (long)i * G + c; if (L >= nwg) return false;
        int wgid = (int)L; { const int q = nwg / NXCD, r = nwg % NXCD, xcd = wgid % NXCD, off = wgid / NXCD; wgid = (xcd < r ? xcd * (q + 1) : r * (q + 1) + (xcd - r) * q) + off; }
        const int nig = WGM * nN, gid = wgid / nig, fm = gid * WGM, gsz = (nM - fm) < WGM ? (nM - fm) : WGM;
        u.pm = fm + ((wgid % nig) % gsz); u.pn = (wgid % nig) / gsz; return true;
    }
    __device__ __forceinline__ void a_ready(const Unit&) const {}
    __device__ __forceinline__ void done(const Unit&) const {}
};

__device__ __forceinline__ unsigned cvt_pk_bf16(float lo, float hi) { return pk2(lo, hi); }
struct EpiProj {
    static constexpr bool PERM = true, AFTER_DRAIN = false;
    bf16_t* O; int ldc;
    __device__ __forceinline__ void operator()(const f32x4 (&acc)[2][2][4][2], const Unit& u, int wr, int wc, int fr, int fq) const {
        const int row0 = u.pm * BM + wr * 64 + fr, col0 = u.pn * BM + wc * 32 + 8 * fq;
#pragma unroll
        for (int ai = 0; ai < 2; ++ai)
#pragma unroll
            for (int m = 0; m < 4; ++m) { bf16_t* rowp = O + (size_t)(row0 + ai * HALF + m * 16) * ldc + col0;
#pragma unroll
                for (int bj = 0; bj < 2; ++bj) { const f32x4 v0 = acc[ai][bj][m][0], v1 = acc[ai][bj][m][1];
                    u32x4 w; w.x = cvt_pk_bf16(v0[0], v0[1]); w.y = cvt_pk_bf16(v0[2], v0[3]); w.z = cvt_pk_bf16(v1[0], v1[1]); w.w = cvt_pk_bf16(v1[2], v1[3]);
                    *(u32x4*)(rowp + bj * HALF) = w; } }
    }
};
struct EpiGlu {
    static constexpr bool PERM = true, AFTER_DRAIN = false;
    const bf16_t* G5; const bf16_t* proj; bf16_t* A2; const float* bias;
    __device__ __forceinline__ void operator()(const f32x4 (&acc)[2][2][4][2], const Unit& u, int wr, int wc, int fr, int fq) const {
        const int row0 = u.pm * BM + wr * 64 + fr, col0 = u.pn * BM + wc * 32 + 8 * fq;
#pragma unroll
        for (int bj = 0; bj < 2; ++bj) {
            const int col = col0 + bj * HALF;
            const f32x4 b0 = *(const f32x4*)(bias + col), b1 = *(const f32x4*)(bias + col + 4);
#pragma unroll
            for (int ai = 0; ai < 2; ++ai)
#pragma unroll
                for (int m = 0; m < 4; ++m) { const size_t row = (size_t)(row0 + ai * HALF + m * 16);
                    const u32x4 g = *(const u32x4*)(G5 + row * 512 + col); const u32x4 s = *(const u32x4*)(proj + row * NPROJ + PC_SG + col);
                    const f32x4 v0 = acc[ai][bj][m][0] + b0, v1 = acc[ai][bj][m][1] + b1;
                    float o[8];
                    o[0] = lo16(g.x) * sigmoid_f(v0[0]) * silu_f(lo16(s.x)); o[1] = hi16(g.x) * sigmoid_f(v0[1]) * silu_f(hi16(s.x));
                    o[2] = lo16(g.y) * sigmoid_f(v0[2]) * silu_f(lo16(s.y)); o[3] = hi16(g.y) * sigmoid_f(v0[3]) * silu_f(hi16(s.y));
                    o[4] = lo16(g.z) * sigmoid_f(v1[0]) * silu_f(lo16(s.z)); o[5] = hi16(g.z) * sigmoid_f(v1[1]) * silu_f(hi16(s.z));
                    o[6] = lo16(g.w) * sigmoid_f(v1[2]) * silu_f(lo16(s.w)); o[7] = hi16(g.w) * sigmoid_f(v1[3]) * silu_f(hi16(s.w));
                    u32x4 w; w.x = cvt_pk_bf16(o[0], o[1]); w.y = cvt_pk_bf16(o[2], o[3]); w.z = cvt_pk_bf16(o[4], o[5]); w.w = cvt_pk_bf16(o[6], o[7]);
                    *(u32x4*)(A2 + row * LDA2 + 1536 + col) = w; }
        }
    }
};
struct EpiRes {
    static constexpr bool PERM = false, AFTER_DRAIN = false;
    const float* srcP; const float* srcS; float* xout; int row_off;
    __device__ __forceinline__ void operator()(const f32x4 (&acc)[2][2][4][2], const Unit& u, int wr, int wc, int fr, int fq) const {
        const int row0 = row_off + u.pm * BM + wr * 64 + fr, col0 = u.pn * BM + wc * 32 + 4 * fq;
        const float* sb = (row_off + u.pm * BM < NP) ? srcP : (srcS - (size_t)NP * D);
#pragma unroll
        for (int ai = 0; ai < 2; ++ai)
#pragma unroll
            for (int m = 0; m < 4; ++m) { const size_t ro = (size_t)(row0 + ai * HALF + m * 16) * D + col0;
#pragma unroll
                for (int bj = 0; bj < 2; ++bj)
#pragma unroll
                    for (int n = 0; n < 2; ++n) { const f32x4 r = *(const f32x4*)(sb + ro + bj * HALF + n * 16); *(f32x4*)(xout + ro + bj * HALF + n * 16) = acc[ai][bj][m][n] + r; } }
    }
};
struct EpiPart {
    static constexpr bool PERM = false, AFTER_DRAIN = false;
    float* part;
    __device__ __forceinline__ void operator()(const f32x4 (&acc)[2][2][4][2], const Unit& u, int wr, int wc, int fr, int fq) const {
        const int row0 = u.pm * BM + wr * 64 + fr, col0 = u.pn * BM + wc * 32 + 4 * fq;
#pragma unroll
        for (int ai = 0; ai < 2; ++ai)
#pragma unroll
            for (int m = 0; m < 4; ++m) { const size_t ro = (size_t)(row0 + ai * HALF + m * 16) * D + col0;
#pragma unroll
                for (int bj = 0; bj < 2; ++bj)
#pragma unroll
                    for (int n = 0; n < 2; ++n) *(f32x4*)(part + ro + bj * HALF + n * 16) = acc[ai][bj][m][n]; }
    }
};

template <class Epi, class Sched, bool ALIGN_EPI = false, bool SP2 = false>
__device__ __forceinline__ void gemm_phase(PG8_LAS unsigned char* lds, const Gemm g, const Sched& S, const Epi& E) {
    int tid_ = threadIdx.x; asm volatile("" : "+v"(tid_)); const int tid = tid_, wid = __builtin_amdgcn_readfirstlane(tid >> 6), lane = tid & 63, wr = wid >> 2, wc = wid & 3, fr = lane & 15, fq = lane >> 4;
    const int K = g.K, nt = K / BK;
    unsigned voffA[2], voffB[2];
#pragma unroll
    for (int i = 0; i < 2; ++i) { int R, C; stage_rc(tid * 16 + i * 8192, R, C); const int Rb = Epi::PERM ? ((R & ~31) + perm32(R & 31)) : R;
        voffA[i] = (unsigned)(R * g.lda + C) * 2u; voffB[i] = (unsigned)(Rb * g.ldb + C) * 2u; }
    const size_t kstep = (size_t)(BK * 2);
    const size_t hstepA = (size_t)HALF * g.lda * 2, hstepB = (size_t)HALF * g.ldb * 2;
    const size_t tstepA = 2 * hstepA, tstepB = 2 * hstepB;
    const unsigned ldsw = (unsigned)wid * 1024u;
    const int aoff = lds_byte(wr * 64 + fr, fq * 8), boff = lds_byte(wc * 32 + fr, fq * 8);
#define PG8_SA(b, h) (((b) * 2 + (h)) * HTB)
#define PG8_SB(b, h) ((4 + (b) * 2 + (h)) * HTB)
#define PG8_STAGE(bufoff, gbase, voff) do { _Pragma("unroll") for (int _i = 0; _i < 2; ++_i) \
        __builtin_amdgcn_global_load_lds((const unsigned*)((const char*)(gbase) + (voff)[_i]), (PG8_LAS unsigned*)(lds + (bufoff) + ldsw + _i * 8192), 16, 0, 0); } while (0)
#define PG8_LDA(dst, b, h) do { _Pragma("unroll") for (int m = 0; m < 4; ++m) _Pragma("unroll") for (int k = 0; k < 2; ++k) dst[m][k] = *(const PG8_LAS bf16x8*)(lds + PG8_SA(b, h) + aoff + m * 2048 + k * 1024); } while (0)
#define PG8_LDB(dst, b, h) do { _Pragma("unroll") for (int n = 0; n < 2; ++n) _Pragma("unroll") for (int k = 0; k < 2; ++k) dst[n][k] = *(const PG8_LAS bf16x8*)(lds + PG8_SB(b, h) + boff + n * 2048 + k * 1024); } while (0)
#define PG8_MMA(ai, bj, At, Bt) do { __builtin_amdgcn_s_setprio(1); _Pragma("unroll") for (int m = 0; m < 4; ++m) _Pragma("unroll") for (int n = 0; n < 2; ++n) _Pragma("unroll") for (int k = 0; k < 2; ++k) \
        acc[ai][bj][m][n] = __builtin_amdgcn_mfma_f32_16x16x32_bf16(Bt[n][k], At[m][k], acc[ai][bj][m][n], 0, 0, 0); __builtin_amdgcn_s_setprio(0); } while (0)
#define PG8_WAIT_V(n) asm volatile("s_waitcnt vmcnt(" #n ")" ::: "memory")
#define PG8_WAIT_L(n) asm volatile("s_waitcnt lgkmcnt(" #n ")" ::: "memory")
#define PG8_BAR __builtin_amdgcn_s_barrier()
#define PG8_SCHED __builtin_amdgcn_sched_barrier(0)
    Unit cur, nxt; int ui = 0;
    if (!S.next(0, cur)) return;
    f32x4 acc[2][2][4][2];
#pragma unroll
    for (int a = 0; a < 2; ++a)
#pragma unroll
        for (int b = 0; b < 2; ++b)
#pragma unroll
            for (int m = 0; m < 4; ++m)
#pragma unroll
                for (int n = 0; n < 2; ++n) acc[a][b][m][n] = (f32x4){0.f, 0.f, 0.f, 0.f};
    bf16x8 At[4][2], B0[2][2], B1[2][2];
    const char* cA = (const char*)g.A + (size_t)cur.pm * tstepA; const char* cB = (const char*)g.Bt + (size_t)cur.pn * tstepB;
    S.a_ready(cur);
    if constexpr (SP2) {
        PG8_STAGE(PG8_SB(0, 0), cB, voffB); PG8_STAGE(PG8_SB(0, 1), cB + hstepB, voffB); PG8_STAGE(PG8_SA(0, 0), cA, voffA); PG8_STAGE(PG8_SA(0, 1), cA + hstepA, voffA);
        if (wr == 1) PG8_BAR;
        PG8_WAIT_V(2); PG8_BAR;
        PG8_STAGE(PG8_SB(1, 0), cB + kstep, voffB); PG8_STAGE(PG8_SA(1, 0), cA + kstep, voffA); PG8_STAGE(PG8_SB(1, 1), cB + hstepB + kstep, voffB);
        PG8_WAIT_V(6); PG8_BAR;
    } else {
        PG8_STAGE(PG8_SB(0, 0), cB, voffB); PG8_STAGE(PG8_SA(0, 0), cA, voffA); PG8_STAGE(PG8_SB(0, 1), cB + hstepB, voffB); PG8_STAGE(PG8_SA(0, 1), cA + hstepA, voffA);
        if (wr == 1) PG8_BAR;
        PG8_WAIT_V(4); PG8_BAR;
        PG8_STAGE(PG8_SB(1, 0), cB + kstep, voffB); PG8_STAGE(PG8_SA(1, 0), cA + kstep, voffA); PG8_STAGE(PG8_SB(1, 1), cB + hstepB + kstep, voffB);
        PG8_WAIT_V(6); PG8_BAR;
    }
    for (;;) {
        const bool has_next = S.next(ui + 1, nxt);
        const char* nA = has_next ? (const char*)g.A + (size_t)nxt.pm * tstepA : cA; const char* nB = has_next ? (const char*)g.Bt + (size_t)nxt.pn * tstepB : cB;
        for (int t = 0; t < nt; t += 2) {
            const bool last = (t == nt - 2);
            const char* a1 = cA + (size_t)(t + 1) * kstep;
            const char* a2 = last ? nA : cA + (size_t)(t + 2) * kstep; const char* b2 = last ? nB : cB + (size_t)(t + 2) * kstep;
            const char* a3 = a2 + kstep; const char* b3 = b2 + kstep;
            if (last && has_next) S.a_ready(nxt);
            if constexpr (SP2) {
            PG8_LDB(B0, 0, 0); PG8_LDB(B1, 0, 1); PG8_SCHED; PG8_LDA(At, 0, 0); PG8_STAGE(PG8_SA(1, 1), a1 + hstepA, voffA);
            PG8_WAIT_V(8); PG8_WAIT_L(0); PG8_BAR; PG8_MMA(0, 0, At, B0); PG8_MMA(0, 1, At, B1); PG8_BAR; PG8_SCHED;
            PG8_LDA(At, 0, 1); PG8_STAGE(PG8_SB(0, 0), b2, voffB); PG8_STAGE(PG8_SB(0, 1), b2 + hstepB, voffB); PG8_STAGE(PG8_SA(0, 0), a2, voffA);
            PG8_WAIT_V(8); PG8_WAIT_L(0); PG8_BAR; PG8_MMA(1, 0, At, B0); PG8_MMA(1, 1, At, B1); PG8_BAR; PG8_SCHED;
            PG8_LDB(B0, 1, 0); PG8_LDB(B1, 1, 1); PG8_SCHED; PG8_LDA(At, 1, 0); PG8_STAGE(PG8_SA(0, 1), a2 + hstepA, voffA);
            PG8_WAIT_V(8); PG8_WAIT_L(0); PG8_BAR; PG8_MMA(0, 0, At, B0); PG8_MMA(0, 1, At, B1); PG8_BAR; PG8_SCHED;
            PG8_LDA(At, 1, 1); PG8_STAGE(PG8_SB(1, 0), b3, voffB); PG8_STAGE(PG8_SB(1, 1), b3 + hstepB, voffB); PG8_STAGE(PG8_SA(1, 0), a3, voffA);
            PG8_WAIT_V(8); PG8_WAIT_L(0); PG8_BAR; PG8_MMA(1, 0, At, B0); PG8_MMA(1, 1, At, B1); PG8_BAR; PG8_SCHED;
            } else {
            PG8_LDB(B0, 0, 0); PG8_SCHED; PG8_LDA(At, 0, 0); PG8_STAGE(PG8_SA(1, 1), a1 + hstepA, voffA);
            PG8_WAIT_L(8); PG8_BAR; PG8_WAIT_L(0); PG8_MMA(0, 0, At, B0); PG8_BAR; PG8_SCHED;
            PG8_LDB(B1, 0, 1); PG8_STAGE(PG8_SB(0, 0), b2, voffB);
            PG8_BAR; PG8_WAIT_L(0); PG8_MMA(0, 1, At, B1); PG8_BAR;
            PG8_LDA(At, 0, 1); PG8_STAGE(PG8_SA(0, 0), a2, voffA);
            PG8_BAR; PG8_WAIT_L(0); PG8_MMA(1, 0, At, B0); PG8_BAR; PG8_SCHED;
            PG8_STAGE(PG8_SB(0, 1), b2 + hstepB, voffB);
            PG8_WAIT_V(6); PG8_BAR; PG8_MMA(1, 1, At, B1); PG8_BAR;
            PG8_LDB(B0, 1, 0); PG8_SCHED; PG8_LDA(At, 1, 0); PG8_STAGE(PG8_SA(0, 1), a2 + hstepA, voffA);
            PG8_WAIT_L(8); PG8_BAR; PG8_WAIT_L(0); PG8_MMA(0, 0, At, B0); PG8_BAR; PG8_SCHED;
            PG8_LDB(B1, 1, 1); PG8_STAGE(PG8_SB(1, 0), b3, voffB);
            PG8_BAR; PG8_WAIT_L(0); PG8_MMA(0, 1, At, B1); PG8_BAR;
            PG8_LDA(At, 1, 1); PG8_STAGE(PG8_SA(1, 0), a3, voffA);
            PG8_BAR; PG8_WAIT_L(0); PG8_MMA(1, 0, At, B0); PG8_BAR; PG8_SCHED;
            PG8_STAGE(PG8_SB(1, 1), b3 + hstepB, voffB);
            PG8_WAIT_V(6); PG8_BAR; PG8_MMA(1, 1, At, B1); PG8_BAR;
            }
        }
        if constexpr (ALIGN_EPI) { if (wr == 0) PG8_BAR; }
        if constexpr (!Epi::AFTER_DRAIN) { E(acc, cur, wr, wc, fr, fq); S.done(cur); }
        if (!has_next) break;
#pragma unroll
        for (int a = 0; a < 2; ++a)
#pragma unroll
            for (int b = 0; b < 2; ++b)
#pragma unroll
                for (int m = 0; m < 4; ++m)
#pragma unroll
                    for (int n = 0; n < 2; ++n) acc[a][b][m][n] = (f32x4){0.f, 0.f, 0.f, 0.f};
        cur = nxt; cA = nA; cB = nB; ++ui;
        if constexpr (ALIGN_EPI) { if (wr == 1) PG8_BAR; }
    }
    PG8_WAIT_V(0);
    if constexpr (!ALIGN_EPI) { if (wr == 0) PG8_BAR; }
    PG8_BAR;
    if constexpr (Epi::AFTER_DRAIN) { E.fused(acc, cur, wr, wc, fr, fq, lds, wid, lane); S.done(cur); }
#undef PG8_SA
#undef PG8_SB
#undef PG8_STAGE
#undef PG8_LDA
#undef PG8_LDB
#undef PG8_MMA
#undef PG8_WAIT_V
#undef PG8_WAIT_L
#undef PG8_BAR
#undef PG8_SCHED
}
}

__device__ __forceinline__ void transpose_item(const float* src, int ldw, int k0, int sc0, bf16_t* dst, int dstK, int n0, const float* kscale, LAS float* scr, int lane, int valid = 32) {
    float v[32];
    const bool ok = (lane & 31) < valid; const int cl = ok ? (lane & 31) : 0;
#pragma unroll
    for (int i = 0; i < 32; ++i) { const int kk = 2 * i + (lane >> 5); const float t_ = src[(size_t)(k0 + kk) * ldw + sc0 + cl]; v[i] = ok ? t_ : 0.f; }
    if (kscale) {
#pragma unroll
        for (int i = 0; i < 32; ++i) v[i] *= kscale[k0 + 2 * i + (lane >> 5)]; }
#pragma unroll
    for (int i = 0; i < 32; ++i) scr[(2 * i + (lane >> 5)) * 33 + (lane & 31)] = v[i];
    asm volatile("s_waitcnt lgkmcnt(0)" ::: "memory");
    const int c = lane & 7;
#pragma unroll
    for (int j = 0; j < 4; ++j) { const int n = (lane >> 3) + 8 * j; const LAS float* s = scr + (8 * c) * 33 + n;
        u32x4 o; o.x = pk2(s[0], s[33]); o.y = pk2(s[2 * 33], s[3 * 33]); o.z = pk2(s[4 * 33], s[5 * 33]); o.w = pk2(s[6 * 33], s[7 * 33]);
        *(u32x4*)(dst + (size_t)(n0 + n) * dstK + k0 + 8 * c) = o; }
    asm volatile("s_waitcnt lgkmcnt(0)" ::: "memory");
}
__device__ __forceinline__ void p0_phase(AP a, LAS unsigned char* lds) {
    int tid_ = threadIdx.x; asm volatile("" : "+v"(tid_)); const int lane = tid_ & 63, w = __builtin_amdgcn_readfirstlane(tid_ >> 6);
    LAS float* scr = (LAS float*)lds + w * (64 * 33 + 32);
    constexpr int I_IN = 16 * 168, I_OUT = 32 * 32, I_GLU = 8 * 16, I_L = I_IN + I_OUT + I_GLU;
    for (int it = blockIdx.x * 8 + w; it < DEPTH * I_L; it += gridDim.x * 8) {
        const int l = it / I_L; int r = it % I_L;
        if (r < I_IN) { const int kb = r / 168, nb = r % 168, n0 = nb * 32;
            const int sc0 = n0 < 3072 ? n0 : (n0 < 5120 ? n0 + 16 : 3072), valid = n0 < 5120 ? 32 : (n0 == 5120 ? 16 : 0);
            transpose_item(a->in[9] + (size_t)l * D * INDIM, INDIM, kb * 64, sc0, (bf16_t*)(a->ws + WS_WTIN) + (size_t)l * NPROJ * LDHB, LDHB, n0, nullptr, scr, lane, valid); continue; }
        r -= I_IN;
        if (r < I_OUT) { const int kb = r / 32, nb = r % 32;
            transpose_item(a->in[33] + (size_t)l * 2048 * D, D, kb * 64, nb * 32, (bf16_t*)(a->ws + WS_WTOUT) + (size_t)l * D * LDA2, LDA2, nb * 32, (kb < 16) ? (a->in[15] + l * 1024) : nullptr, scr, lane); continue; }
        r -= I_OUT;
        { const int kb = r / 16, nb = r % 16;
            transpose_item(a->in[31] + (size_t)l * 512 * 512, 512, kb * 64, nb * 32, (bf16_t*)(a->ws + WS_WTGLU) + (size_t)l * 512 * 512, 512, nb * 32, nullptr, scr, lane); }
    }
    __syncthreads();
}
__device__ __forceinline__ void norm_phase(AP a, int l, int row_lo, int row_hi, int blk_lo, int nblk, const float* part = nullptr, const float* resP = nullptr, const float* resS = nullptr) {
    int tid_ = threadIdx.x; asm volatile("" : "+v"(tid_)); const int tid = tid_, lane = tid & 63, w = tid >> 6;
    const int bi = (int)blockIdx.x - blk_lo; if (bi < 0 || bi >= nblk) return;
    const float* srcP = (l == 0) ? a->in[0] : (const float*)(a->ws + WS_XB);
    const float* srcS = (l == 0) ? a->in[1] : (const float*)(a->ws + WS_XB) + (size_t)NP * D;
    const float* g = (l < DEPTH) ? (a->in[8] + l * D) : a->in[34];
    f32x4 gv[4];
#pragma unroll
    for (int j = 0; j < 4; ++j) gv[j] = *(const f32x4*)(g + 4 * lane + 256 * j);
    bf16_t* hb = (bf16_t*)(a->ws + WS_HB);
    const int stride = nblk * 8;
    for (int row = row_lo + bi * 8 + w; row < row_hi; row += 2 * stride) {
        const int row2 = row + stride; const bool has2 = row2 < row_hi; const int r2 = has2 ? row2 : row;
        const float* xr = (row < NP) ? (srcP + (size_t)row * D) : (srcS + (size_t)(row - NP) * D);
        const float* xq = (r2 < NP) ? (srcP + (size_t)r2 * D) : (srcS + (size_t)(r2 - NP) * D);
        f32x4 v[4], q[4]; float s = 0.f, s2 = 0.f;
#pragma unroll
        for (int j = 0; j < 4; ++j) { v[j] = *(const f32x4*)(xr + 4 * lane + 256 * j); q[j] = *(const f32x4*)(xq + 4 * lane + 256 * j); }
        if (part) {
            const float* r0 = resS + (size_t)(row - NP) * D; const float* r1 = resS + (size_t)(r2 - NP) * D;
            float* xo0 = (float*)(a->ws + WS_XB) + (size_t)row * D; float* xo1 = (float*)(a->ws + WS_XB) + (size_t)r2 * D;
#pragma unroll
            for (int j = 0; j < 4; ++j) { const int c = 4 * lane + 256 * j; f32x4 s0 = *(const f32x4*)(r0 + c), s1 = *(const f32x4*)(r1 + c);
#pragma unroll
                for (int ks = 0; ks < 4; ++ks) { s0 += *(const f32x4*)(part + ((size_t)ks * NSR + (row - NP)) * D + c); s1 += *(const f32x4*)(part + ((size_t)ks * NSR + (r2 - NP)) * D + c); }
                v[j] = s0; q[j] = s1; *(f32x4*)(xo0 + c) = s0; if (has2) *(f32x4*)(xo1 + c) = s1; }
        }
#pragma unroll
        for (int j = 0; j < 4; ++j) { s += (v[j].x * v[j].x + v[j].y * v[j].y) + (v[j].z * v[j].z + v[j].w * v[j].w); s2 += (q[j].x * q[j].x + q[j].y * q[j].y) + (q[j].z * q[j].z + q[j].w * q[j].w); }
        const float rs = rsqrtf(wave_sum(s) * (1.f / D) + EPS), rs2 = rsqrtf(wave_sum(s2) * (1.f / D) + EPS);
#pragma unroll
        for (int j = 0; j < 4; ++j) { v[j] = v[j] * rs * gv[j]; q[j] = q[j] * rs2 * gv[j]; }
        if (l < DEPTH) {
#pragma unroll
            for (int j = 0; j < 4; ++j) { u32x2 o; o.x = pk2(v[j].x, v[j].y); o.y = pk2(v[j].z, v[j].w); *(u32x2*)(hb + (size_t)row * LDHB + 4 * lane + 256 * j) = o; }
            if (has2) {
#pragma unroll
                for (int j = 0; j < 4; ++j) { u32x2 o; o.x = pk2(q[j].x, q[j].y); o.y = pk2(q[j].z, q[j].w); *(u32x2*)(hb + (size_t)row2 * LDHB + 4 * lane + 256 * j) = o; } }
        } else {
#pragma unroll
            for (int j = 0; j < 4; ++j) *(f32x4*)(a->out + O_YP + (size_t)row * D + 4 * lane + 256 * j) = v[j];
            if (has2) {
#pragma unroll
                for (int j = 0; j < 4; ++j) *(f32x4*)(a->out + O_YP + (size_t)row2 * D + 4 * lane + 256 * j) = q[j]; }
        }
    }
}
__device__ __forceinline__ void ssdnorm_rows(AP a, int blk_lo, int nblk) {
    int tid_ = threadIdx.x; asm volatile("" : "+v"(tid_)); const int tid = tid_, lane = tid & 63, w = tid >> 6;
    bf16_t* A2 = (bf16_t*)(a->ws + WS_A2); const float* ssq = (const float*)(a->ws + WS_SSQ);
    const int bi = (int)blockIdx.x - blk_lo; if (bi < 0 || bi >= nblk) return;
    const int stride = nblk * 8;
    for (int row = bi * 8 + w; row < MT; row += 2 * stride) {
        const int row2 = row + stride; const bool has2 = row2 < MT; const int r2 = has2 ? row2 : row;
        float s = (lane < 32) ? ssq[(size_t)row * 32 + lane] : 0.f, t = (lane < 32) ? ssq[(size_t)r2 * 32 + lane] : 0.f;
        u32x4* p0 = (u32x4*)(A2 + (size_t)row * LDA2 + 8 * lane); u32x4* p1 = (u32x4*)(A2 + (size_t)r2 * LDA2 + 8 * lane);
        u32x4 va = p0[0], vb = p0[64], vc = p1[0], vd = p1[64];
        const float rs = rsqrtf(wave_sum(s) * (1.f / 1024.f) + EPS), rt = rsqrtf(wave_sum(t) * (1.f / 1024.f) + EPS);
#define SN_SCALE(v, r) do { v.x = pk2(lo16(v.x) * r, hi16(v.x) * r); v.y = pk2(lo16(v.y) * r, hi16(v.y) * r); v.z = pk2(lo16(v.z) * r, hi16(v.z) * r); v.w = pk2(lo16(v.w) * r, hi16(v.w) * r); } while (0)
        SN_SCALE(va, rs); SN_SCALE(vb, rs); p0[0] = va; p0[64] = vb;
        if (has2) { SN_SCALE(vc, rt); SN_SCALE(vd, rt); p1[0] = vc; p1[64] = vd; }
#undef SN_SCALE
    }
}

__device__ __forceinline__ void conv_phase(AP a, int l) {
    asm volatile("" : "+s"(a));
    int tid_ = threadIdx.x; asm volatile("" : "+v"(tid_)); const int tid = tid_;
    const bf16_t* proj = (const bf16_t*)(a->ws + WS_PROJ); bf16_t* XBC = (bf16_t*)(a->ws + WS_XBC);
    const int col = tid & 255, c8 = col * 8;
    float wk[4][8], bs[8];
    { const float* cw = a->in[10] + (size_t)l * 4 * 2048 + c8; const float* cb = a->in[11] + l * 2048 + c8;
#pragma unroll
      for (int k = 0; k < 4; ++k) { const f32x4 w0 = *(const f32x4*)(cw + k * 2048), w1 = *(const f32x4*)(cw + k * 2048 + 4);
          wk[k][0] = w0.x; wk[k][1] = w0.y; wk[k][2] = w0.z; wk[k][3] = w0.w; wk[k][4] = w1.x; wk[k][5] = w1.y; wk[k][6] = w1.z; wk[k][7] = w1.w; }
      const f32x4 b0 = *(const f32x4*)cb, b1 = *(const f32x4*)(cb + 4); bs[0] = b0.x; bs[1] = b0.y; bs[2] = b0.z; bs[3] = b0.w; bs[4] = b1.x; bs[5] = b1.y; bs[6] = b1.z; bs[7] = b1.w; }
#define CV_UNPACK(dst, r) do { dst[0] = lo16(r.x); dst[1] = hi16(r.x); dst[2] = lo16(r.y); dst[3] = hi16(r.y); dst[4] = lo16(r.z); dst[5] = hi16(r.z); dst[6] = lo16(r.w); dst[7] = hi16(r.w); } while (0)
#define CV_OUT(dstp, x0, x1, x2, x3) do { float o_[8]; _Pragma("unroll") for (int e = 0; e < 8; ++e) o_[e] = silu_f(bs[e] + wk[0][e] * x0[e] + wk[1][e] * x1[e] + wk[2][e] * x2[e] + wk[3][e] * x3[e]); \
        u32x4 pk_; pk_.x = pk2(o_[0], o_[1]); pk_.y = pk2(o_[2], o_[3]); pk_.z = pk2(o_[4], o_[5]); pk_.w = pk2(o_[6], o_[7]); *(u32x4*)(dstp) = pk_; } while (0)
    for (int run = blockIdx.x * 2 + (tid >> 8); run < NP / 32; run += gridDim.x * 2) {
        const int r0 = run * 32; const bool first = (r0 % SEQ) == 0;
        const bf16_t* src = proj + (size_t)r0 * NPROJ + PC_X + c8; bf16_t* dst = XBC + (size_t)r0 * 2048 + c8;
        float xa[8], xb[8], xc[8], xd[8];
        if (first) {
#pragma unroll
            for (int e = 0; e < 8; ++e) { xa[e] = 0.f; xb[e] = 0.f; xc[e] = 0.f; }
        } else { const u32x4 ra = *(const u32x4*)(src - 3 * (size_t)NPROJ), rb = *(const u32x4*)(src - 2 * (size_t)NPROJ), rc = *(const u32x4*)(src - (size_t)NPROJ); CV_UNPACK(xa, ra); CV_UNPACK(xb, rb); CV_UNPACK(xc, rc); }
        u32x4 n0 = *(const u32x4*)(src), n1 = *(const u32x4*)(src + (size_t)NPROJ), n2 = *(const u32x4*)(src + (size_t)2 * NPROJ), n3 = *(const u32x4*)(src + (size_t)3 * NPROJ);
#pragma unroll 1
        for (int t = 0; t < 32; t += 4) {
            const u32x4 q0 = n0, q1 = n1, q2 = n2, q3 = n3;
            if (t + 4 < 32) { n0 = *(const u32x4*)(src + (size_t)(t + 4) * NPROJ); n1 = *(const u32x4*)(src + (size_t)(t + 5) * NPROJ); n2 = *(const u32x4*)(src + (size_t)(t + 6) * NPROJ); n3 = *(const u32x4*)(src + (size_t)(t + 7) * NPROJ); }
            CV_UNPACK(xd, q0); CV_OUT(dst + (size_t)(t + 0) * 2048, xa, xb, xc, xd);
            CV_UNPACK(xa, q1); CV_OUT(dst + (size_t)(t + 1) * 2048, xb, xc, xd, xa);
            CV_UNPACK(xb, q2); CV_OUT(dst + (size_t)(t + 2) * 2048, xc, xd, xa, xb);
            CV_UNPACK(xc, q3); CV_OUT(dst + (size_t)(t + 3) * 2048, xd, xa, xb, xc);
        }
        if ((r0 % SEQ) == SEQ - 32) {
            float* co = a->out + O_SCP + ((size_t)l * BATCH + r0 / SEQ) * 3 * 2048 + c8;
            *(f32x4*)(co) = (f32x4){xa[0], xa[1], xa[2], xa[3]}; *(f32x4*)(co + 4) = (f32x4){xa[4], xa[5], xa[6], xa[7]};
            *(f32x4*)(co + 2048) = (f32x4){xb[0], xb[1], xb[2], xb[3]}; *(f32x4*)(co + 2048 + 4) = (f32x4){xb[4], xb[5], xb[6], xb[7]};
            *(f32x4*)(co + 4096) = (f32x4){xc[0], xc[1], xc[2], xc[3]}; *(f32x4*)(co + 4096 + 4) = (f32x4){xc[4], xc[5], xc[6], xc[7]}; }
    }
    for (int sq = blockIdx.x * 2 + (tid >> 8); sq < DBATCH; sq += gridDim.x * 2) {
        const int r0 = NP + sq * DSEQ;
        const bf16_t* src = proj + (size_t)r0 * NPROJ + PC_X + c8; bf16_t* dst = XBC + (size_t)r0 * 2048 + c8;
        const float* cst = a->in[3] + ((size_t)l * DBATCH + sq) * 3 * 2048 + c8;
        float xa[8], xb[8], xc[8], xd[8];
        { const f32x4 a0 = *(const f32x4*)cst, a1 = *(const f32x4*)(cst + 4), b0 = *(const f32x4*)(cst + 2048), b1 = *(const f32x4*)(cst + 2048 + 4), c0 = *(const f32x4*)(cst + 4096), c1 = *(const f32x4*)(cst + 4096 + 4);
          xa[0] = a0.x; xa[1] = a0.y; xa[2] = a0.z; xa[3] = a0.w; xa[4] = a1.x; xa[5] = a1.y; xa[6] = a1.z; xa[7] = a1.w;
          xb[0] = b0.x; xb[1] = b0.y; xb[2] = b0.z; xb[3] = b0.w; xb[4] = b1.x; xb[5] = b1.y; xb[6] = b1.z; xb[7] = b1.w;
          xc[0] = c0.x; xc[1] = c0.y; xc[2] = c0.z; xc[3] = c0.w; xc[4] = c1.x; xc[5] = c1.y; xc[6] = c1.z; xc[7] = c1.w; }
#pragma unroll 1
        for (int t = 0; t < 8; t += 4) {
            const u32x4 q0 = *(const u32x4*)(src + (size_t)(t + 0) * NPROJ), q1 = *(const u32x4*)(src + (size_t)(t + 1) * NPROJ), q2 = *(const u32x4*)(src + (size_t)(t + 2) * NPROJ), q3 = *(const u32x4*)(src + (size_t)(t + 3) * NPROJ);
            CV_UNPACK(xd, q0); CV_OUT(dst + (size_t)(t + 0) * 2048, xa, xb, xc, xd);
            CV_UNPACK(xa, q1); CV_OUT(dst + (size_t)(t + 1) * 2048, xb, xc, xd, xa);
            CV_UNPACK(xb, q2); CV_OUT(dst + (size_t)(t + 2) * 2048, xc, xd, xa, xb);
            CV_UNPACK(xc, q3); CV_OUT(dst + (size_t)(t + 3) * 2048, xd, xa, xb, xc);
        }
        { float* co = a->out + O_SCS + ((size_t)l * DBATCH + sq) * 3 * 2048 + c8;
            *(f32x4*)(co) = (f32x4){xa[0], xa[1], xa[2], xa[3]}; *(f32x4*)(co + 4) = (f32x4){xa[4], xa[5], xa[6], xa[7]};
            *(f32x4*)(co + 2048) = (f32x4){xb[0], xb[1], xb[2], xb[3]}; *(f32x4*)(co + 2048 + 4) = (f32x4){xb[4], xb[5], xb[6], xb[7]};
            *(f32x4*)(co + 4096) = (f32x4){xc[0], xc[1], xc[2], xc[3]}; *(f32x4*)(co + 4096 + 4) = (f32x4){xc[4], xc[5], xc[6], xc[7]}; }
    }
    { float* DT = (float*)(a->ws + WS_DTRAW); float dtb[16];
#pragma unroll
      for (int hd = 0; hd < 16; ++hd) dtb[hd] = a->in[12][l * 16 + hd];
      for (int row = blockIdx.x * 512 + tid; row < MT; row += gridDim.x * 512) {
          const u32x4 d0 = *(const u32x4*)(proj + (size_t)row * NPROJ + PC_DT), d1 = *(const u32x4*)(proj + (size_t)row * NPROJ + PC_DT + 8);
          float dv[16]; CV_UNPACK(dv, d0); { float* dv8 = dv + 8; CV_UNPACK(dv8, d1); }
#pragma unroll
          for (int hd = 0; hd < 16; ++hd) DT[(size_t)hd * MT + row] = softplus_f(dv[hd] + dtb[hd]); } }
#undef CV_UNPACK
#undef CV_OUT
}

#define LBAR() do { asm volatile("s_waitcnt lgkmcnt(0)" ::: "memory"); __builtin_amdgcn_s_barrier(); asm volatile("" ::: "memory"); } while (0)

typedef short bf16x8 __attribute__((ext_vector_type(8)));
constexpr int XT_S = 72, BC_S = 136;
__device__ __forceinline__ f32x4 mfma16(bf16x8 a, bf16x8 b, f32x4 c) { return __builtin_amdgcn_mfma_f32_16x16x32_bf16(a, b, c, 0, 0, 0); }
__device__ __forceinline__ void ssd_mfma_unit(AP a, int l, int b, int hd, LAS unsigned char* lds) {
    asm volatile("" : "+s"(a));
#define XTI(r_, t_) ((r_) * XT_S + ((t_) ^ ((((r_) >> 3) & 7) << 3)))
#define XTC(r_, c_) ((r_) * XT_S + ((((c_)) ^ (((r_) >> 3) & 7)) << 3))
    int tid_ = threadIdx.x; asm volatile("" : "+v"(tid_)); const int tid = tid_, w = __builtin_amdgcn_readfirstlane(tid >> 6);
    const int g = hd >> 2, row0 = b * SEQ;
    LAS bf16_t* Xt = (LAS bf16_t*)lds;
    LAS bf16_t* Xwt = Xt + 64 * XT_S;
    LAS bf16_t* Bs = Xwt + 64 * XT_S;
    LAS bf16_t* Cs = Bs + 64 * BC_S;
    LAS bf16_t* Bt = Cs + 64 * BC_S;
    LAS bf16_t* Ps = Bt + 128 * XT_S;
    LAS bf16_t* Hs0 = Ps + 64 * XT_S;
    LAS float* dts0 = (LAS float*)(Hs0 + 2 * 64 * BC_S);
    LAS float* acs0 = dts0 + 128;
    const bf16_t* proj = (const bf16_t*)(a->ws + WS_PROJ); const bf16_t* XBC = (const bf16_t*)(a->ws + WS_XBC);
    bf16_t* A2 = (bf16_t*)(a->ws + WS_A2); float* ssq = (float*)(a->ws + WS_SSQ);
    const float aneg = -fexp(a->in[13][l * 16 + hd]), Dh = a->in[14][l * 16 + hd]; const float* DT = (const float*)(a->ws + WS_DTRAW);
    for (int idx = tid; idx < 64 * BC_S / 2; idx += 512) ((LAS unsigned*)Hs0)[idx] = 0u;
#define SSD_ITEM(j) const int i_ = tid + 512 * (j); const int t = i_ / 40, vc = i_ - t * 40
    u32x4 pre[5]; float dtr_a = 0.f, dtr_b = 0.f; u32x2 zzn[2];
    const int lane0 = tid & 63;
#define SSD_PREFETCH(t0_) do { _Pragma("unroll") for (int j = 0; j < 5; ++j) { SSD_ITEM(j); \
        const int col = vc < 8 ? hd * 64 + vc * 8 : (vc < 24 ? 1024 + g * 128 + (vc - 8) * 8 : 1536 + g * 128 + (vc - 24) * 8); \
        pre[j] = *(const u32x4*)(XBC + (size_t)(row0 + (t0_) + t) * 2048 + col); } \
        _Pragma("unroll") for (int h2 = 0; h2 < 2; ++h2) zzn[h2] = *(const u32x2*)(proj + (size_t)(row0 + (t0_) + (w >> 1) * 16 + (lane0 & 15)) * NPROJ + PC_Z + hd * 64 + ((w & 1) * 2 + h2) * 16 + (lane0 >> 4) * 4); \
        dtr_b = ((t0_) + 64 < SEQ) ? DT[(size_t)hd * MT + row0 + (t0_) + 64 + lane0] : 0.f; } while (0)
#define SSD_SCAN(dtv_, buf_) do { const float dt_ = (dtv_); float s_ = dt_ * aneg; \
        _Pragma("unroll") for (int o = 1; o < 64; o <<= 1) { const float t_ = __shfl_up(s_, o); if (lane0 >= o) s_ += t_; } \
        dts0[(buf_) * 64 + lane0] = dt_; acs0[(buf_) * 64 + lane0] = s_; } while (0)
    SSD_PREFETCH(0);
    if (w == 1) { const float d0 = DT[(size_t)hd * MT + row0 + lane0]; SSD_SCAN(d0, 0); }
    dtr_a = dtr_b;
    f32x4 hacc[4];
#pragma unroll
    for (int pt = 0; pt < 4; ++pt) hacc[pt] = (f32x4){0.f, 0.f, 0.f, 0.f};
    __syncthreads();
    for (int c = 0; c < SEQ / 64; ++c) {
        const int t0 = c * 64;
        int tl_ = tid; asm volatile("" : "+v"(tl_)); const int lane = tl_ & 63, fr = lane & 15, quad = lane >> 4;
        LAS bf16_t* Hcur = Hs0 + (c & 1) * 64 * BC_S; LAS bf16_t* Hnxt = Hs0 + ((c & 1) ^ 1) * 64 * BC_S;
        LAS float* dts = dts0 + (c & 1) * 64; LAS float* acs = acs0 + (c & 1) * 64;
        const float aend = acs[63];
#pragma unroll
        for (int j = 0; j < 5; ++j) { SSD_ITEM(j); const u32x4 r = pre[j];
            const int tsw = t ^ ((vc & 7) << 3);
            if (vc < 8) { const float wgt = fexp(aend - acs[t]) * dts[t]; LAS bf16_t* xp = Xt + (vc * 8) * XT_S + tsw; LAS bf16_t* wp = Xwt + (vc * 8) * XT_S + tsw;
                xp[0 * XT_S] = (bf16_t)(r.x & 0xffffu); xp[1 * XT_S] = (bf16_t)(r.x >> 16); xp[2 * XT_S] = (bf16_t)(r.y & 0xffffu); xp[3 * XT_S] = (bf16_t)(r.y >> 16);
                xp[4 * XT_S] = (bf16_t)(r.z & 0xffffu); xp[5 * XT_S] = (bf16_t)(r.z >> 16); xp[6 * XT_S] = (bf16_t)(r.w & 0xffffu); xp[7 * XT_S] = (bf16_t)(r.w >> 16);
                const unsigned s0 = pk2(lo16(r.x) * wgt, hi16(r.x) * wgt), s1 = pk2(lo16(r.y) * wgt, hi16(r.y) * wgt), s2 = pk2(lo16(r.z) * wgt, hi16(r.z) * wgt), s3 = pk2(lo16(r.w) * wgt, hi16(r.w) * wgt);
                wp[0 * XT_S] = (bf16_t)(s0 & 0xffffu); wp[1 * XT_S] = (bf16_t)(s0 >> 16); wp[2 * XT_S] = (bf16_t)(s1 & 0xffffu); wp[3 * XT_S] = (bf16_t)(s1 >> 16);
                wp[4 * XT_S] = (bf16_t)(s2 & 0xffffu); wp[5 * XT_S] = (bf16_t)(s2 >> 16); wp[6 * XT_S] = (bf16_t)(s3 & 0xffffu); wp[7 * XT_S] = (bf16_t)(s3 >> 16);
            } else if (vc < 24) { const int n0 = (vc - 8) * 8; LAS bf16_t* bp = Bt + n0 * XT_S + tsw;
                *(LAS u32x4*)(Bs + t * BC_S + n0) = r;
                bp[0 * XT_S] = (bf16_t)(r.x & 0xffffu); bp[1 * XT_S] = (bf16_t)(r.x >> 16); bp[2 * XT_S] = (bf16_t)(r.y & 0xffffu); bp[3 * XT_S] = (bf16_t)(r.y >> 16);
                bp[4 * XT_S] = (bf16_t)(r.z & 0xffffu); bp[5 * XT_S] = (bf16_t)(r.z >> 16); bp[6 * XT_S] = (bf16_t)(r.w & 0xffffu); bp[7 * XT_S] = (bf16_t)(r.w >> 16);
            } else { const int n0 = (vc - 24) * 8; *(LAS u32x4*)(Cs + t * BC_S + n0) = r; } }
        LBAR();
        u32x2 zz[2]; zz[0] = zzn[0]; zz[1] = zzn[1];
        const float dscan = dtr_a;
        if (c + 1 < SEQ / 64) { SSD_PREFETCH(t0 + 64); dtr_a = dtr_b; }
        if (w == 1 && c + 1 < SEQ / 64) SSD_SCAN(dscan, (c + 1) & 1);
        const int qt = w >> 1, q = qt * 16 + fr; const size_t rowq = (size_t)(row0 + t0 + q);
#pragma unroll
        for (int h2 = 0; h2 < 2; ++h2) { __builtin_amdgcn_sched_barrier(0); const int ti = 2 * w + h2, qt2 = ti >> 2, st = ti & 3; f32x4 acc = (f32x4){0.f, 0.f, 0.f, 0.f};
            if (st <= qt2) { bf16x8 av[4], bv[4];
#pragma unroll
                for (int kk = 0; kk < 4; ++kk) { av[kk] = *(const LAS bf16x8*)(Bs + (st * 16 + fr) * BC_S + kk * 32 + quad * 8); bv[kk] = *(const LAS bf16x8*)(Cs + (qt2 * 16 + fr) * BC_S + kk * 32 + quad * 8); }
#pragma unroll
                for (int kk = 0; kk < 4; ++kk) acc = mfma16(av[kk], bv[kk], acc); }
            const int q2 = qt2 * 16 + fr; const float aq = acs[q2]; float pv[4];
#pragma unroll
            for (int j = 0; j < 4; ++j) { const int s = st * 16 + quad * 4 + j; const float e = fexp(fminf(aq - acs[s], 0.f)) * dts[s]; pv[j] = (s <= q2) ? acc[j] * e : 0.f; }
            u32x2 pk; pk.x = pk2(pv[0], pv[1]); pk.y = pk2(pv[2], pv[3]); *(LAS u32x2*)(Ps + q2 * XT_S + st * 16 + quad * 4) = pk; }
        LBAR();
        { const float eq = fexp(acs[q]); float s2 = 0.f;
#pragma unroll
          for (int h2 = 0; h2 < 2; ++h2) { __builtin_amdgcn_sched_barrier(0); const int pt = (w & 1) * 2 + h2; f32x4 acc = (f32x4){0.f, 0.f, 0.f, 0.f};
              bf16x8 av[6], bv[6];
#pragma unroll
              for (int kk = 0; kk < 4; ++kk) { av[kk] = *(const LAS bf16x8*)(Hcur + (pt * 16 + fr) * BC_S + kk * 32 + quad * 8); bv[kk] = *(const LAS bf16x8*)(Cs + (qt * 16 + fr) * BC_S + kk * 32 + quad * 8); }
#pragma unroll
              for (int kk = 0; kk < 2; ++kk) { av[4 + kk] = *(const LAS bf16x8*)(Xt + XTC(pt * 16 + fr, kk * 4 + quad)); bv[4 + kk] = *(const LAS bf16x8*)(Ps + (qt * 16 + fr) * XT_S + kk * 32 + quad * 8); }
#pragma unroll
              for (int kk = 0; kk < 4; ++kk) acc = mfma16(av[kk], bv[kk], acc);
              acc = acc * eq;
#pragma unroll
              for (int kk = 0; kk < 2; ++kk) acc = mfma16(av[4 + kk], bv[4 + kk], acc);
              const int p0 = pt * 16 + quad * 4;
              const float z0 = lo16(zz[h2].x), z1 = hi16(zz[h2].x), z2 = lo16(zz[h2].y), z3 = hi16(zz[h2].y);
              const float u0 = (acc[0] + Dh * bf2f(Xt[XTI(p0 + 0, q)])) * silu_f(z0), u1 = (acc[1] + Dh * bf2f(Xt[XTI(p0 + 1, q)])) * silu_f(z1);
              const float u2 = (acc[2] + Dh * bf2f(Xt[XTI(p0 + 2, q)])) * silu_f(z2), u3 = (acc[3] + Dh * bf2f(Xt[XTI(p0 + 3, q)])) * silu_f(z3);
              s2 += (u0 * u0 + u1 * u1) + (u2 * u2 + u3 * u3);
              u32x2 o; o.x = pk2(u0, u1); o.y = pk2(u2, u3); *(u32x2*)(A2 + rowq * LDA2 + hd * 64 + p0) = o; }
          s2 += __shfl_xor(s2, 16); s2 += __shfl_xor(s2, 32);
          if (quad == 0) ssq[rowq * 32 + hd * 2 + (w & 1)] = s2; }
        { const float dec = fexp(aend);
          bf16x8 ea[2], eb[4][2];
#pragma unroll
          for (int kk = 0; kk < 2; ++kk) { ea[kk] = *(const LAS bf16x8*)(Bt + XTC(w * 16 + fr, kk * 4 + quad));
#pragma unroll
              for (int pt = 0; pt < 4; ++pt) eb[pt][kk] = *(const LAS bf16x8*)(Xwt + XTC(pt * 16 + fr, kk * 4 + quad)); }
#pragma unroll
          for (int pt = 0; pt < 4; ++pt) { f32x4 acc = hacc[pt] * dec;
#pragma unroll
              for (int kk = 0; kk < 2; ++kk) acc = mfma16(ea[kk], eb[pt][kk], acc);
              hacc[pt] = acc;
              u32x2 o; o.x = pk2(acc[0], acc[1]); o.y = pk2(acc[2], acc[3]); *(LAS u32x2*)(Hnxt + (pt * 16 + fr) * BC_S + w * 16 + quad * 4) = o; } }
        LBAR();
    }
#undef XTI
#undef XTC
#undef SSD_SCAN
#undef SSD_PREFETCH
#undef SSD_ITEM
    const int fr = tid & 15, quad = (tid & 63) >> 4;
#pragma unroll
    for (int pt = 0; pt < 4; ++pt) *(f32x4*)(a->out + O_SSDP + ((((size_t)l * BATCH + b) * 16 + hd) * 64 + pt * 16 + fr) * 128 + w * 16 + quad * 4) = hacc[pt];
}

__device__ __forceinline__ void ssd_sample_unit(AP a, int l, int b, int g, LAS unsigned char* lds) {
    asm volatile("" : "+s"(a));
    int tid_ = threadIdx.x; asm volatile("" : "+v"(tid_)); const int tid = tid_;
    const int row0 = NP + b * DSEQ;
    LAS float* xs = (LAS float*)lds;
    LAS float* Bs = xs + 2048;
    LAS float* Cs = Bs + 1024;
    LAS float* ys = Cs + 1024;
    LAS float* dts = ys + 2048;
    LAS float* dAs = dts + 32;
    const bf16_t* proj = (const bf16_t*)(a->ws + WS_PROJ); const bf16_t* XBC = (const bf16_t*)(a->ws + WS_XBC);
    bf16_t* A2 = (bf16_t*)(a->ws + WS_A2); float* ssq = (float*)(a->ws + WS_SSQ);
    const int p = tid >> 3, nq = tid & 7;
    float h[4][16];
#pragma unroll
    for (int hh = 0; hh < 4; ++hh) { const f32x4* s = (const f32x4*)(a->in[2] + ((((size_t)l * DBATCH + b) * 16 + g * 4 + hh) * 64 + p) * 128 + nq * 16);
#pragma unroll
        for (int j = 0; j < 4; ++j) { const f32x4 v = s[j]; h[hh][4 * j] = v.x; h[hh][4 * j + 1] = v.y; h[hh][4 * j + 2] = v.z; h[hh][4 * j + 3] = v.w; } }
    const int et = tid >> 6, ec = (tid & 63) * 4, eh = (tid & 63) >> 4;
    const u32x2 zz = *(const u32x2*)(proj + (size_t)(row0 + et) * NPROJ + PC_Z + g * 256 + ec);
    const float Dh = a->in[14][l * 16 + g * 4 + eh];
    { const int t = tid >> 6, vc = tid & 63;
        const int col = vc < 32 ? g * 256 + vc * 8 : (vc < 48 ? 1024 + g * 128 + (vc - 32) * 8 : 1536 + g * 128 + (vc - 48) * 8);
        const u32x4 r = *(const u32x4*)(XBC + (size_t)(row0 + t) * 2048 + col);
        LAS float* dst = vc < 32 ? xs + t * 256 + vc * 8 : (vc < 48 ? Bs + t * 128 + (vc - 32) * 8 : Cs + t * 128 + (vc - 48) * 8);
        *(LAS f32x4*)dst = (f32x4){lo16(r.x), hi16(r.x), lo16(r.y), hi16(r.y)}; *(LAS f32x4*)(dst + 4) = (f32x4){lo16(r.z), hi16(r.z), lo16(r.w), hi16(r.w)}; }
    if (tid < 32) { const int t = tid >> 2, hh = tid & 3, hd = g * 4 + hh; const float dt = ((const float*)(a->ws + WS_DTRAW))[(size_t)hd * MT + row0 + t];
        dts[tid] = dt; dAs[tid] = fexp(-dt * fexp(a->in[13][l * 16 + hd])); }
    LBAR();
#pragma unroll 1
    for (int t = 0; t < 8; ++t) {
        const LAS f32x4* B4 = (const LAS f32x4*)(Bs + t * 128 + nq * 16); const LAS f32x4* C4 = (const LAS f32x4*)(Cs + t * 128 + nq * 16);
        f32x4 bv[4], cv[4];
#pragma unroll
        for (int j = 0; j < 4; ++j) { bv[j] = B4[j]; cv[j] = C4[j]; }
#pragma unroll
        for (int hh = 0; hh < 4; ++hh) { const float dA = dAs[t * 4 + hh], dtx = dts[t * 4 + hh] * xs[t * 256 + hh * 64 + p]; float acc = 0.f;
#pragma unroll
            for (int j = 0; j < 4; ++j) {
                h[hh][4 * j] = dA * h[hh][4 * j] + dtx * bv[j].x; acc += cv[j].x * h[hh][4 * j];
                h[hh][4 * j + 1] = dA * h[hh][4 * j + 1] + dtx * bv[j].y; acc += cv[j].y * h[hh][4 * j + 1];
                h[hh][4 * j + 2] = dA * h[hh][4 * j + 2] + dtx * bv[j].z; acc += cv[j].z * h[hh][4 * j + 2];
                h[hh][4 * j + 3] = dA * h[hh][4 * j + 3] + dtx * bv[j].w; acc += cv[j].w * h[hh][4 * j + 3]; }
            acc += __shfl_xor(acc, 1); acc += __shfl_xor(acc, 2); acc += __shfl_xor(acc, 4);
            if (nq == 0) ys[t * 256 + hh * 64 + p] = acc; }
    }
#pragma unroll
    for (int hh = 0; hh < 4; ++hh) { f32x4* o = (f32x4*)(a->out + O_SSDS + ((((size_t)l * DBATCH + b) * 16 + g * 4 + hh) * 64 + p) * 128 + nq * 16);
#pragma unroll
        for (int j = 0; j < 4; ++j) { f32x4 v; v.x = h[hh][4 * j]; v.y = h[hh][4 * j + 1]; v.z = h[hh][4 * j + 2]; v.w = h[hh][4 * j + 3]; o[j] = v; } }
    LBAR();
    { const size_t row = (size_t)(row0 + et);
        const float z0 = lo16(zz.x), z1 = hi16(zz.x), z2 = lo16(zz.y), z3 = hi16(zz.y);
        const f32x4 yv = *(const LAS f32x4*)(ys + et * 256 + ec), xv = *(const LAS f32x4*)(xs + et * 256 + ec);
        const float u0 = (yv.x + Dh * xv.x) * silu_f(z0), u1 = (yv.y + Dh * xv.y) * silu_f(z1), u2 = (yv.z + Dh * xv.z) * silu_f(z2), u3 = (yv.w + Dh * xv.w) * silu_f(z3);
        float s2 = (u0 * u0 + u1 * u1) + (u2 * u2 + u3 * u3);
        u32x2 o; o.x = pk2(u0, u1); o.y = pk2(u2, u3); *(u32x2*)(A2 + row * LDA2 + g * 256 + ec) = o;
        s2 += __shfl_xor(s2, 1); s2 += __shfl_xor(s2, 2); s2 += __shfl_xor(s2, 4); s2 += __shfl_xor(s2, 8);
        if ((tid & 15) == 0) { ssq[row * 32 + (g * 4 + eh) * 2] = s2; ssq[row * 32 + (g * 4 + eh) * 2 + 1] = 0.f; } }
}

__device__ __forceinline__ void lru_unit(AP a, int l, bool isS, int bq, int k, LAS unsigned char* lds) {
    asm volatile("" : "+s"(a));
    int tid_ = threadIdx.x; asm volatile("" : "+v"(tid_)); const int tid = tid_, j = tid & 63, w = __builtin_amdgcn_readfirstlane(tid >> 6), ch = k * 64 + j;
    LAS bf16_t* Xr = (LAS bf16_t*)lds;
    LAS bf16_t* Wt = Xr + 64 * XT_S;
    LAS float* G = (LAS float*)(Wt + 128 * XT_S);
    LAS float* cA = G + 64 * 132;
    LAS float* cH = cA + 512;
    const bf16_t* proj = (const bf16_t*)(a->ws + WS_PROJ); bf16_t* A2 = (bf16_t*)(a->ws + WS_A2);
    { const float* wa = a->in[18] + (size_t)(l * 8 + k) * 4096; const float* wx = a->in[20] + (size_t)(l * 8 + k) * 4096;
      float ta[8], tx[8];
#pragma unroll
      for (int r = 0; r < 8; ++r) { ta[r] = wa[tid + 512 * r]; tx[r] = wx[tid + 512 * r]; }
#pragma unroll
      for (int r = 0; r < 8; ++r) { const int idx = tid + 512 * r, i = idx >> 6, jj = idx & 63; Wt[jj * XT_S + i] = f2bf(ta[r]); Wt[(64 + jj) * XT_S + i] = f2bf(tx[r]); } }
    const float ba = a->in[19][l * 512 + ch], bx = a->in[21][l * 512 + ch], sp = softplus_f(-a->in[22][l * 512 + ch]);
    const float cw0 = a->in[16][(l * 4 + 0) * 512 + ch], cw1 = a->in[16][(l * 4 + 1) * 512 + ch], cw2 = a->in[16][(l * 4 + 2) * 512 + ch], cw3 = a->in[16][(l * 4 + 3) * 512 + ch], cbias = a->in[17][l * 512 + ch];
    const int nb = isS ? DBATCH : BATCH;
    float H = 0.f, Hn = 0.f;
    const int ntile = isS ? DBATCH / 8 : SEQ / 64;
    bf16_t vr[11], gr[8]; float vf[3] = {0.f, 0.f, 0.f}; const unsigned choff = (unsigned)ch * 2u;
#define LRU_PREFETCH(ti_) do { const int bs_ = isS ? (ti_) * 8 + w : bq; const int ti0_ = isS ? 0 : (ti_) * 64 + w * 8; const size_t rw_ = (size_t)((isS ? NP + bs_ * DSEQ : bs_ * SEQ) + ti0_); \
        const float* cst_ = a->in[5] + (size_t)(l * DBATCH + bs_) * 3 * 512; \
        const char* bx_ = (const char*)proj + ((rw_ - 3) * NPROJ + PC_LX) * 2; const char* gx_ = (const char*)proj + (rw_ * NPROJ + PC_LG) * 2;     \
        if (isS) { _Pragma("unroll") for (int i = 0; i < 3; ++i) vf[i] = cst_[i * 512 + ch]; _Pragma("unroll") for (int i = 3; i < 11; ++i) vr[i] = *(const bf16_t*)(bx_ + (size_t)i * (NPROJ * 2) + choff); } \
        else if (ti0_ >= 3) { _Pragma("unroll") for (int i = 0; i < 11; ++i) vr[i] = *(const bf16_t*)(bx_ + (size_t)i * (NPROJ * 2) + choff); } \
        else { _Pragma("unroll") for (int i = 0; i < 11; ++i) { const int tk = ti0_ - 3 + i; vr[i] = (tk >= 0) ? *(const bf16_t*)(bx_ + (size_t)i * (NPROJ * 2) + choff) : (bf16_t)0; } } \
        _Pragma("unroll") for (int tl = 0; tl < 8; ++tl) gr[tl] = *(const bf16_t*)(gx_ + (size_t)tl * (NPROJ * 2) + choff); \
        if (isS) Hn = a->in[4][(size_t)(l * DBATCH + bs_) * 512 + ch]; } while (0)
    LRU_PREFETCH(0);
    for (int ti = 0; ti < ntile; ++ti) {
        int tl_ = tid; asm volatile("" : "+v"(tl_)); const int lane = tl_ & 63, fr = lane & 15, quad = lane >> 4;
        const int bseq = isS ? ti * 8 + w : bq; const int rowseq = isS ? NP + bseq * DSEQ : bseq * SEQ;
        const int ti0 = isS ? 0 : ti * 64 + w * 8; const size_t rw = (size_t)(rowseq + ti0);
        if (isS) H = Hn;
        float v[11], gt[8];
#pragma unroll
        for (int i = 0; i < 11; ++i) v[i] = (isS && i < 3) ? vf[i] : bf2f(vr[i]);
#pragma unroll
        for (int tl = 0; tl < 8; ++tl) gt[tl] = bf2f(gr[tl]);
        const float cs5 = v[8], cs6 = v[9], cs7 = v[10];
        float xr[8], gg[8];
#pragma unroll
        for (int tl = 0; tl < 8; ++tl) { xr[tl] = cbias + cw0 * v[tl] + cw1 * v[tl + 1] + cw2 * v[tl + 2] + cw3 * v[tl + 3]; gg[tl] = gt[tl]; Xr[(w * 8 + tl) * XT_S + lane] = f2bf(xr[tl]); }
        LBAR();
        if (ti + 1 < ntile) LRU_PREFETCH(ti + 1);
#pragma unroll
        for (int tt = 0; tt < 4; ++tt) { __builtin_amdgcn_sched_barrier(0); f32x4 acc = (f32x4){0.f, 0.f, 0.f, 0.f};
#pragma unroll
            for (int kk = 0; kk < 2; ++kk) { const bf16x8 av = *(const LAS bf16x8*)(Wt + (w * 16 + fr) * XT_S + kk * 32 + quad * 8); const bf16x8 bv = *(const LAS bf16x8*)(Xr + (tt * 16 + fr) * XT_S + kk * 32 + quad * 8);
                acc = mfma16(av, bv, acc); }
            *(LAS f32x4*)(G + (tt * 16 + fr) * 132 + w * 16 + quad * 4) = acc; }
        LBAR();
        float hl[8], Ap[8]; float hh = 0.f, aa = 1.f;
#pragma unroll
        for (int tl = 0; tl < 8; ++tl) { const float ra = G[(w * 8 + tl) * 132 + lane] + ba, rx = G[(w * 8 + tl) * 132 + 64 + lane] + bx;
            const float r = sigmoid_f(ra), gi = sigmoid_f(rx); const float la = -8.f * r * sp; const float at = fexp(la);
            const float gain = __builtin_amdgcn_sqrtf(fmaxf(1.f - at * at, 0.f)); const float bt = gain * gi * xr[tl];
            hh = at * hh + bt; aa *= at; hl[tl] = hh; Ap[tl] = aa; }
        float Hw = H, Hend;
        if (!isS) {
            cA[w * 64 + lane] = aa; cH[w * 64 + lane] = hh;
            LBAR();
            float Hin = H;
#pragma unroll
            for (int w2 = 0; w2 < 8; ++w2) { if (w2 == w) Hw = Hin; Hin = cA[w2 * 64 + lane] * Hin + cH[w2 * 64 + lane]; }
            Hend = Hin;
        } else Hend = hl[7] + Ap[7] * H;
        { char* ox = (char*)A2 + (rw * LDA2 + 1024) * 2;
#pragma unroll
          for (int tl = 0; tl < 8; ++tl) { const float hv = hl[tl] + Ap[tl] * Hw; *(bf16_t*)(ox + (size_t)tl * (LDA2 * 2) + choff) = f2bf(hv * silu_f(gg[tl])); } }
        H = Hend;
        if (isS) { a->out[O_LRUS + (size_t)(l * nb + bseq) * 512 + ch] = H;
            float* co = a->out + O_LCS + (size_t)(l * nb + bseq) * 3 * 512; co[ch] = cs5; co[512 + ch] = cs6; co[1024 + ch] = cs7; }
        LBAR();
    }
#undef LRU_PREFETCH
    if (!isS && w == 0) { a->out[O_LRUP + (size_t)(l * nb + bq) * 512 + ch] = H;
        float* co = a->out + O_LCP + (size_t)(l * nb + bq) * 3 * 512;
#pragma unroll
        for (int jj = 0; jj < 3; ++jj) co[jj * 512 + ch] = bf2f(proj[(size_t)(bq * SEQ + SEQ - 3 + jj) * NPROJ + PC_LX + ch]); }
}

__device__ __forceinline__ void s5_unit(AP a, int l, bool isS, int bq, int g, LAS unsigned char* lds) {
    asm volatile("" : "+s"(a));
    int tid_ = threadIdx.x; asm volatile("" : "+v"(tid_)); const int tid = tid_, p = tid & 63, w = __builtin_amdgcn_readfirstlane(tid >> 6);
    LAS float* us = (LAS float*)lds;
    LAS bf16_t* Hc = (LAS bf16_t*)(us + 1024);
    LAS bf16_t* Cc = Hc + 64 * BC_S;
    LAS float* cE = (LAS float*)(Cc + 16 * BC_S);
    LAS float* BU = cE + 1024;
    LAS bf16_t* Bb = (LAS bf16_t*)(BU + 128 * 68);
    LAS bf16_t* us16 = Bb + 128 * 16;
    LAS float* us2 = (LAS float*)(us16 + 2 * 1024);
    const bf16_t* proj = (const bf16_t*)(a->ws + WS_PROJ); bf16_t* G5 = (bf16_t*)(a->ws + WS_G5);
    const int lg = l * 32 + g;
    float ar, ai; float Bre[16], Bim[16];
    { const float delta = fexp(a->in[25][lg]); const float lr = a->in[23][(size_t)lg * 64 + p], li = a->in[24][(size_t)lg * 64 + p];
      const float mag = expf(lr * delta), ang = li * delta; ar = mag * cosf(ang); ai = mag * sinf(ang);
      const float den = lr * lr + li * li, nr = ar - 1.f, ni = ai; const float cr = (nr * lr + ni * li) / den, ci = (ni * lr - nr * li) / den;
      const f32x4* br = (const f32x4*)(a->in[26] + ((size_t)lg * 64 + p) * 16); const f32x4* bi = (const f32x4*)(a->in[27] + ((size_t)lg * 64 + p) * 16);
#pragma unroll
      for (int q = 0; q < 4; ++q) { const f32x4 r4 = br[q], i4 = bi[q];
          Bre[4 * q] = cr * r4.x - ci * i4.x; Bim[4 * q] = cr * i4.x + ci * r4.x; Bre[4 * q + 1] = cr * r4.y - ci * i4.y; Bim[4 * q + 1] = cr * i4.y + ci * r4.y;
          Bre[4 * q + 2] = cr * r4.z - ci * i4.z; Bim[4 * q + 2] = cr * i4.z + ci * r4.z; Bre[4 * q + 3] = cr * r4.w - ci * i4.w; Bim[4 * q + 3] = cr * i4.w + ci * r4.w; } }
    float pr[8], pi[8]; pr[0] = ar; pi[0] = ai;
#pragma unroll
    for (int q = 1; q < 8; ++q) { pr[q] = pr[q - 1] * ar - pi[q - 1] * ai; pi[q] = pr[q - 1] * ai + pi[q - 1] * ar; }
#pragma unroll
    for (int r = 0; r < 2; ++r) { const int idx = tid + 512 * r, h = idx >> 6, pp = idx & 63; Cc[h * BC_S + pp] = f2bf(a->in[28][(size_t)lg * 1024 + idx]); Cc[h * BC_S + 64 + pp] = f2bf(-a->in[29][(size_t)lg * 1024 + idx]); }
    if (w == 0) {
#pragma unroll
        for (int q = 0; q < 4; ++q) { u32x2 o; o.x = pk2(Bre[4 * q], Bre[4 * q + 1]); o.y = pk2(Bre[4 * q + 2], Bre[4 * q + 3]); *(LAS u32x2*)(Bb + p * 16 + 4 * q) = o;
            u32x2 o2; o2.x = pk2(Bim[4 * q], Bim[4 * q + 1]); o2.y = pk2(Bim[4 * q + 2], Bim[4 * q + 3]); *(LAS u32x2*)(Bb + (64 + p) * 16 + 4 * q) = o2; } }
    __syncthreads();
    typedef short bf16x4 __attribute__((ext_vector_type(4)));
    const bf16x4 breg = *(const LAS bf16x4*)(Bb + (w * 16 + (tid & 15)) * 16 + ((tid & 63) >> 4) * 4);
    const int nb = isS ? DBATCH : BATCH;
    float Hr = 0.f, Hi = 0.f, Hrn = 0.f, Hin_ = 0.f;
    if (isS) { Hrn = a->in[6][((size_t)(l * DBATCH + w) * 32 + g) * 64 + p]; Hin_ = a->in[7][((size_t)(l * DBATCH + w) * 32 + g) * 64 + p]; }
    const int ntile = isS ? DBATCH / 8 : SEQ / 64;
    f32x4 dv = *(const f32x4*)(a->in[30] + l * 512 + g * 16 + ((tid & 63) >> 4) * 4);
    const size_t rbase0 = isS ? (size_t)NP : (size_t)(bq * SEQ);
    u32x4 upre = (u32x4){0u, 0u, 0u, 0u};
    if ((unsigned)(tid - 256) < 128u) upre = *(const u32x4*)(proj + (rbase0 + ((tid - 256) >> 1)) * NPROJ + PC_SU + g * 16 + (tid & 1) * 8);
#define S5_STAGE(buf_) do { if ((unsigned)(tid - 256) < 128u) { const int st_ = tid - 256; LAS float* d = ((buf_) ? us2 : us) + (st_ >> 1) * 16 + (st_ & 1) * 8; f32x4 x0, x1; \
        x0.x = lo16(upre.x); x0.y = hi16(upre.x); x0.z = lo16(upre.y); x0.w = hi16(upre.y); x1.x = lo16(upre.z); x1.y = hi16(upre.z); x1.z = lo16(upre.w); x1.w = hi16(upre.w); \
        *(LAS f32x4*)d = x0; *(LAS f32x4*)(d + 4) = x1; *(LAS u32x4*)(us16 + (buf_) * 1024 + (st_ >> 1) * 16 + (st_ & 1) * 8) = upre; } } while (0)
    S5_STAGE(0);
    __syncthreads();
    for (int ti = 0; ti < ntile; ++ti) {
        int tl_ = tid; asm volatile("" : "+v"(tl_)); const int lane = tl_ & 63, fr = lane & 15, quad = lane >> 4;
        const size_t rbase = rbase0 + (size_t)ti * 64;
        const int cb = ti & 1; LAS float* usc = cb ? us2 : us; LAS bf16_t* us16c = us16 + cb * 1024;
        const int bseq = isS ? ti * 8 + w : bq;
        if (isS) { Hr = Hrn; Hi = Hin_; }

        if (ti + 1 < ntile && (unsigned)(tl_ - 256) < 128u) upre = *(const u32x4*)(proj + (rbase + 64 + ((tl_ - 256) >> 1)) * NPROJ + PC_SU + g * 16 + (tl_ & 1) * 8);
        if (isS && ti + 1 < ntile) { Hrn = a->in[6][((size_t)(l * DBATCH + (ti + 1) * 8 + w) * 32 + g) * 64 + p]; Hin_ = a->in[7][((size_t)(l * DBATCH + (ti + 1) * 8 + w) * 32 + g) * 64 + p]; }
#pragma unroll
        for (int tt = 0; tt < 4; ++tt) { const bf16x4 av = *(const LAS bf16x4*)(us16c + (tt * 16 + fr) * 16 + quad * 4);
            const f32x4 acc = __builtin_amdgcn_mfma_f32_16x16x16bf16_1k(av, breg, (f32x4){0.f, 0.f, 0.f, 0.f}, 0, 0, 0);
            *(LAS f32x4*)(BU + (w * 16 + fr) * 68 + tt * 16 + quad * 4) = acc; }
        LBAR();
        float hlr[8], hli[8]; float hr = 0.f, hi = 0.f;
        { const f32x4 r0 = *(const LAS f32x4*)(BU + lane * 68 + w * 8), r1 = *(const LAS f32x4*)(BU + lane * 68 + w * 8 + 4), i0 = *(const LAS f32x4*)(BU + (64 + lane) * 68 + w * 8), i1 = *(const LAS f32x4*)(BU + (64 + lane) * 68 + w * 8 + 4);
          const float bre[8] = {r0.x, r0.y, r0.z, r0.w, r1.x, r1.y, r1.z, r1.w}, bim[8] = {i0.x, i0.y, i0.z, i0.w, i1.x, i1.y, i1.z, i1.w};
#pragma unroll
          for (int tl = 0; tl < 8; ++tl) { const float nr_ = ar * hr - ai * hi + bre[tl], ni_ = ar * hi + ai * hr + bim[tl]; hr = nr_; hi = ni_; hlr[tl] = hr; hli[tl] = hi; } }
        float Hwr = Hr, Hwi = Hi, Her, Hei;
        if (!isS) {
            cE[(w * 64 + lane) * 2] = hr; cE[(w * 64 + lane) * 2 + 1] = hi;
            LBAR();
            float Hinr = Hr, Hini = Hi;
#pragma unroll
            for (int w2 = 0; w2 < 8; ++w2) { if (w2 == w) { Hwr = Hinr; Hwi = Hini; }
                const float er = cE[(w2 * 64 + lane) * 2], ei = cE[(w2 * 64 + lane) * 2 + 1];
                const float tr = pr[7] * Hinr - pi[7] * Hini + er, tq = pr[7] * Hini + pi[7] * Hinr + ei; Hinr = tr; Hini = tq; }
            Her = Hinr; Hei = Hini;
        } else { Her = hlr[7] + pr[7] * Hr - pi[7] * Hi; Hei = hli[7] + pr[7] * Hi + pi[7] * Hr; }
#pragma unroll
        for (int tl = 0; tl < 8; ++tl) { Hc[(w * 8 + tl) * BC_S + lane] = f2bf(hlr[tl] + pr[tl] * Hwr - pi[tl] * Hwi); Hc[(w * 8 + tl) * BC_S + 64 + lane] = f2bf(hli[tl] + pr[tl] * Hwi + pi[tl] * Hwr); }
        Hr = Her; Hi = Hei;
        if (isS) { a->out[O_S5RS + ((size_t)(l * nb + bseq) * 32 + g) * 64 + p] = Hr; a->out[O_S5IS + ((size_t)(l * nb + bseq) * 32 + g) * 64 + p] = Hi; }
        LBAR();
        if (ti + 1 < ntile) S5_STAGE(cb ^ 1);
        if (w < 4) { f32x4 acc = (f32x4){0.f, 0.f, 0.f, 0.f};
#pragma unroll
            for (int kk = 0; kk < 4; ++kk) { const bf16x8 av = *(const LAS bf16x8*)(Cc + fr * BC_S + kk * 32 + quad * 8); const bf16x8 bv = *(const LAS bf16x8*)(Hc + (w * 16 + fr) * BC_S + kk * 32 + quad * 8);
                acc = mfma16(av, bv, acc); }
            const int t = w * 16 + fr; const f32x4 uu = *(const LAS f32x4*)(usc + t * 16 + quad * 4);
            const float y0 = gelu_f(acc[0] + dv.x * uu.x), y1 = gelu_f(acc[1] + dv.y * uu.y), y2 = gelu_f(acc[2] + dv.z * uu.z), y3 = gelu_f(acc[3] + dv.w * uu.w);
            u32x2 o; o.x = pk2(y0, y1); o.y = pk2(y2, y3); *(u32x2*)(G5 + (rbase + t) * 512 + g * 16 + quad * 4) = o; }
        LBAR();
    }
    if (!isS && w == 0) { a->out[O_S5RP + ((size_t)(l * nb + bq) * 32 + g) * 64 + p] = Hr; a->out[O_S5IP + ((size_t)(l * nb + bq) * 32 + g) * 64 + p] = Hi; }
}
#undef S5_STAGE

constexpr int U_LRUP = 0, U_SSDP = U_LRUP + BATCH * 8, U_S5S = U_SSDP + BATCH * 16, U_LRUS = U_S5S + 32, U_S5P = U_LRUS + 8, U_SSDS = U_S5P + BATCH * 32, U_END = U_SSDS + DBATCH * 4;
__device__ __forceinline__ void mixer_phase(AP am, int l, LAS unsigned char* lds, int cidx, int ulo = 0, int uhi = U_END) {
    unsigned* ctr = (unsigned*)(am->ws + WS_CTR) + cidx * 64;
    LAS unsigned* slot = (LAS unsigned*)(lds + LDS_BYTES - 16);
    static_assert(U_LRUP == 0 && U_SSDP == 64 && U_S5S == 192 && U_LRUS == 224 && U_S5P == 232 && U_SSDS == 488 && U_END == 1000, "static placement assumes this queue layout");
    const bool stat = ((int)gridDim.x == 256) && ulo == 0 && uhi == U_END;
    bool first = stat && (int)blockIdx.x < 192;
    for (;;) {
        int u;
        if (first) { const int blk = (int)blockIdx.x, x = blk & 7; first = false;
            if (blk < 64) u = U_LRUP + x * 8 + (blk >> 3);
            else { const int j = (blk - 64) >> 3, pair = x * 4 + (j >> 2); u = U_SSDP + (pair >> 2) * 16 + (pair & 3) * 4 + (j & 3); }
        } else if (stat) {
            const int x = (int)blockIdx.x & 7;
            if (threadIdx.x == 0) *slot = atomicAdd((unsigned*)(am->ws + WS_CTR) + (16 + cidx * 8 + x) * 16, 1u);
            __syncthreads();
            const int q = (int)*slot;
            __syncthreads();
            if (q >= 101) break;
            u = q < 4 ? U_S5S + x * 4 + q : (q == 4 ? U_LRUS + x : (q < 37 ? U_S5P + x * 32 + (q - 5) : U_SSDS + x * 64 + (q - 37)));
        } else {
            if (threadIdx.x == 0) *slot = atomicAdd(ctr, 1u);
            __syncthreads();
            u = (int)*slot + ulo;
            __syncthreads();
        }
        if (u >= uhi) break;
        AP a = am; asm volatile("" : "+s"(a));
        if (u < U_SSDP) lru_unit(a, l, false, (u - U_LRUP) >> 3, (u - U_LRUP) & 7, lds);
        else if (u < U_S5S) ssd_mfma_unit(a, l, (u - U_SSDP) >> 4, (u - U_SSDP) & 15, lds);
        else if (u < U_LRUS) s5_unit(a, l, true, 0, u - U_S5S, lds);
        else if (u < U_S5P) lru_unit(a, l, true, 0, u - U_LRUS, lds);
        else if (u < U_SSDS) s5_unit(a, l, false, (u - U_S5P) >> 5, (u - U_S5P) & 31, lds);
        else ssd_sample_unit(a, l, (u - U_SSDS) >> 2, (u - U_SSDS) & 3, lds);
        __syncthreads();
    }
}

#define XB_TMO      128
#define XB_XCNT(j)  (256  + 64 * (j))
#define XB_XSUB(j)  (1280 + 64 * (j))
#define XB_XGEN(j)  (2304 + 64 * (j))
#define XB_TOP      3328
#define XB_TOPGEN   3392
#define XCD_BAR_WORDS 3456
#define XB_SPIN_CAP (1u << 18)
__device__ __forceinline__ unsigned xb_ld(unsigned* p)              { return __hip_atomic_load(p, __ATOMIC_RELAXED, __HIP_MEMORY_SCOPE_AGENT); }
__device__ __forceinline__ unsigned xb_add(unsigned* p, unsigned v) { return __hip_atomic_fetch_add(p, v, __ATOMIC_RELAXED, __HIP_MEMORY_SCOPE_AGENT); }
__device__ __forceinline__ unsigned xb_xcc_id() { return (unsigned)__builtin_amdgcn_s_getreg((3 << 11) | 20) & 0xFu; }
#define XB_SPIN(cond, bar) do { unsigned _sp = 0; while (cond) { __builtin_amdgcn_s_sleep(1); \
    if ((++_sp & 255u) == 0u) { if (xb_ld(&(bar)[XB_TMO])) break; if (_sp > XB_SPIN_CAP) { atomicAdd(&(bar)[XB_TMO], 1u); break; } } } } while (0)
struct XcdBarrier { unsigned* bar; unsigned x; volatile LAS unsigned* st; };
__device__ __forceinline__ void xcd_barrier_complete(unsigned* bar, unsigned x, unsigned& nloc, unsigned& nx) {
    const unsigned G = gridDim.x * gridDim.y * gridDim.z;
    unsigned sum, cnt, mine, sp = 0u;
    for (;;) {
        sum = 0u; cnt = 0u; mine = 0u;
#pragma unroll
        for (unsigned j = 0; j < 16; ++j) { const unsigned c = xb_ld(&bar[XB_XCNT(j)]); sum += c; cnt += (c > 0u) ? 1u : 0u; mine = (j == x) ? c : mine; }
        if (sum == G) break;
        __builtin_amdgcn_s_sleep(1);
        if ((++sp & 255u) == 0u) { if (xb_ld(&bar[XB_TMO])) break; if (sp > XB_SPIN_CAP) { atomicAdd(&bar[XB_TMO], 1u); break; } }
    }
    nloc = mine > 0u ? mine : 1u; nx = cnt > 0u ? cnt : 1u;
}
__device__ __forceinline__ void xcd_barrier(const XcdBarrier& b) {
    asm volatile("s_waitcnt vmcnt(0)" ::: "memory");
    __syncthreads();
    if (threadIdx.x == 0) {
        unsigned* bar = b.bar;
        __builtin_amdgcn_s_waitcnt(0);
        unsigned nloc = b.st[0], nx = b.st[1];
        if (nloc == 0u) { xcd_barrier_complete(bar, b.x, nloc, nx); b.st[0] = nloc; b.st[1] = nx; }
        const unsigned old = xb_add(&bar[XB_XSUB(b.x)], 1u);
        const unsigned gen = old / nloc;
        if (old + 1u == (gen + 1u) * nloc) {
            __builtin_amdgcn_fence(__ATOMIC_RELEASE, "agent");
            asm volatile("s_waitcnt vmcnt(0)" ::: "memory");
            const unsigned og = xb_add(&bar[XB_TOP], 1u);
            const unsigned tg = og / nx;
            if (og + 1u == (tg + 1u) * nx) xb_add(&bar[XB_TOPGEN], 1u);
            else XB_SPIN(xb_ld(&bar[XB_TOPGEN]) == tg, bar);
            __builtin_amdgcn_fence(__ATOMIC_ACQUIRE, "agent");
            xb_add(&bar[XB_XGEN(b.x)], 1u);
            asm volatile("s_waitcnt vmcnt(0)" ::: "memory");
        } else {
            XB_SPIN(xb_ld(&bar[XB_XGEN(b.x)]) == gen, bar);
            __builtin_amdgcn_fence(__ATOMIC_ACQUIRE, "agent");
            asm volatile("s_waitcnt vmcnt(0)" ::: "memory");
        }
    }
    __syncthreads();
}

__global__ void __launch_bounds__(512, 2) mega(Args a_) {
    extern __shared__ __attribute__((aligned(16))) unsigned char smem[];
    LAS unsigned char* lds = (LAS unsigned char*)smem;
    cg::grid_group grid = cg::this_grid();
    AP a0 = (AP)__builtin_amdgcn_kernarg_segment_ptr();
    const int lo = a0->ph_lo, hi = a0->ph_hi;
    volatile LAS unsigned* xst = (volatile LAS unsigned*)(lds + 131072);
    if (threadIdx.x == 0) { xst[0] = 0u; xst[1] = 0u; (void)xb_add((unsigned*)(a0->ws + WS_BAR) + XB_XCNT(xb_xcc_id()), 1u); }
    __syncthreads();
#define IN(k) (lo <= (k) && (k) < hi)
#define SEAM(k) do { if (hi - lo > 1) { XcdBarrier xb_; xb_.bar = (unsigned*)(a0->ws + WS_BAR); xb_.x = xb_xcc_id(); xb_.st = xst; xcd_barrier(xb_); } } while (0)
#define FRESH(a) AP a = a0; asm volatile("" : "+s"(a))
    if (IN(0)) { { FRESH(a); p0_phase(a, lds); } { FRESH(a); norm_phase(a, 0, 0, MT, 0, (int)gridDim.x); } }
    if (hi < 0) grid.sync();
    SEAM(0);
#pragma unroll 1
    for (int l = 0; l < DEPTH; ++l) {
        const int pb = 1 + 6 * l;
        if (IN(pb)) {
            FRESH(a);
            pg8::Gemm g{(const bf16_t*)(a->ws + WS_HB), (const bf16_t*)(a->ws + WS_WTIN) + (size_t)l * NPROJ * LDHB, MT, NPROJ, D, LDHB, LDHB};
            pg8::StaticOrder S; S.init(MT, NPROJ, (int)gridDim.x, (int)blockIdx.x);
            pg8::EpiProj E{(bf16_t*)(a->ws + WS_PROJ), NPROJ};
            pg8::gemm_phase<pg8::EpiProj, pg8::StaticOrder, true, true>(lds, g, S, E);
        }
        SEAM(pb);
        if (IN(pb + 5)) { FRESH(a); conv_phase(a, l); }
        SEAM(pb + 5);
        if (IN(pb + 1)) { FRESH(a); mixer_phase(a, l, lds, l); }
        SEAM(pb + 1);
        if (IN(pb + 2)) {
            { FRESH(a);
            pg8::Gemm g{(const bf16_t*)(a->ws + WS_G5), (const bf16_t*)(a->ws + WS_WTGLU) + (size_t)l * 512 * 512, MT, 512, 512, 512, 512};
            pg8::StaticOrder S; S.init(MT, 512, (int)gridDim.x, (int)blockIdx.x);
            pg8::EpiGlu E{(const bf16_t*)(a->ws + WS_G5), (const bf16_t*)(a->ws + WS_PROJ), (bf16_t*)(a->ws + WS_A2), a->in[32] + l * 512};
            pg8::gemm_phase<pg8::EpiGlu, pg8::StaticOrder, true, true>(lds, g, S, E); }
            { FRESH(a); const int G = (int)gridDim.x; if (G > 200) ssdnorm_rows(a, 136, G - 136); else ssdnorm_rows(a, 0, G); }
        }
        SEAM(pb + 2);
        if (IN(pb + 3)) {
            FRESH(a);
            pg8::Gemm g{(const bf16_t*)(a->ws + WS_A2), (const bf16_t*)(a->ws + WS_WTOUT) + (size_t)l * D * LDA2, NP, D, 2048, LDA2, LDA2};
            pg8::StaticOrder S; S.init(NP, D, (int)gridDim.x, (int)blockIdx.x);
            pg8::EpiRes E{l == 0 ? a->in[0] : (const float*)(a->ws + WS_XB), l == 0 ? a->in[1] : (const float*)(a->ws + WS_XB) + (size_t)NP * D, (float*)(a->ws + WS_XB), 0};
            pg8::gemm_phase<pg8::EpiRes, pg8::StaticOrder, true, true>(lds, g, S, E);
        }
        SEAM(pb + 3);
        if (IN(pb + 4)) {
            const int G = (int)gridDim.x, ns = G > 128 ? 64 : 0;
            { FRESH(a);
            const int c = (int)blockIdx.x, ks = c & 3;
            pg8::Gemm g{(const bf16_t*)(a->ws + WS_A2) + (size_t)NP * LDA2 + ks * 512, (const bf16_t*)(a->ws + WS_WTOUT) + (size_t)l * D * LDA2 + ks * 512, NSR, D, 512, LDA2, LDA2};
            pg8::StaticOrder S; S.init(NSR, D, G, c < 64 ? (c >> 2) : 16);
            pg8::EpiPart E{(float*)(a->ws + WS_G5) + (size_t)ks * NSR * D};
            pg8::gemm_phase<pg8::EpiPart, pg8::StaticOrder, true, true>(lds, g, S, E); }
            { FRESH(a); norm_phase(a, l + 1, 0, NP, ns, G - ns); }
        }
        SEAM(pb + 4);
        { FRESH(a); norm_phase(a, l + 1, NP, MT, 0, (int)gridDim.x, (const float*)(a->ws + WS_G5), nullptr, l == 0 ? a->in[1] : (const float*)(a->ws + WS_XB) + (size_t)NP * D); }
        if (l + 1 < DEPTH) SEAM(pb + 4);
    }
#undef IN
#undef SEAM
}

#ifndef MK_PER_PHASE
#define MK_PER_PHASE 0
#endif
extern "C" void kernel_launch(void* const* d_in, const int* in_sizes, int n_in, void* d_out, int out_size, void* d_ws, size_t ws_size, hipStream_t stream) {
    static int grid = 0;
    if (grid == 0) {
        if (n_in != 35 || (size_t)out_size != O_END || ws_size < WS_END) { fprintf(stderr, "kernel_launch: unexpected shapes n_in %d out %d ws %zu (need %zu)\n", n_in, out_size, ws_size, (size_t)WS_END); grid = -1; return; }
        int dev = 0, cus = 0, per_cu = 0;
        if (hipGetDevice(&dev) != hipSuccess || hipDeviceGetAttribute(&cus, hipDeviceAttributeMultiprocessorCount, dev) != hipSuccess) { grid = -1; return; }
        if (hipFuncSetAttribute((const void*)mega, hipFuncAttributeMaxDynamicSharedMemorySize, LDS_BYTES) != hipSuccess) { fprintf(stderr, "kernel_launch: hipFuncSetAttribute failed\n"); grid = -1; return; }
        if (hipOccupancyMaxActiveBlocksPerMultiprocessor(&per_cu, (const void*)mega, 512, LDS_BYTES) != hipSuccess || per_cu < 1) fprintf(stderr, "kernel_launch: occupancy query says %d\n", per_cu);
        (void)hipGetLastError();
        grid = cus;
    }
    if (grid < 0) return;
    (void)hipMemsetAsync((char*)d_ws + WS_CTR, 0, 4096 + 16384, stream);
    Args a{};
    for (int i = 0; i < 35; ++i) a.in[i] = (const float*)d_in[i];
    a.out = (float*)d_out; a.ws = (unsigned char*)d_ws;
#if MK_PER_PHASE
    for (int ph = 0; ph < NPH; ++ph) { a.ph_lo = ph; a.ph_hi = ph + 1; hipLaunchKernelGGL(mega, dim3(grid), dim3(512), LDS_BYTES, stream, a); }
#else
    a.ph_lo = 0; a.ph_hi = NPH;
    void* args[] = {&a};
    const hipError_t e = hipLaunchCooperativeKernel((const void*)mega, dim3(grid), dim3(512), args, LDS_BYTES, stream);
    if (e != hipSuccess) fprintf(stderr, "kernel_launch: cooperative launch failed: %s (grid %d)\n", hipGetErrorString(e), grid);
#endif
}
```

```cpp
#include <hip/hip_runtime.h>
#include <hip/hip_cooperative_groups.h>
#include <cstdio>
#include <cstdint>
namespace cg = cooperative_groups;

#define LAS __attribute__((address_space(3)))
typedef unsigned short bf16_t;
typedef float f32x4 __attribute__((ext_vector_type(4)));
typedef float f32x2 __attribute__((ext_vector_type(2)));
typedef unsigned u32x4 __attribute__((ext_vector_type(4)));
typedef unsigned u32x2 __attribute__((ext_vector_type(2)));

constexpr int D = 1024, NP = 16384, NSR = 1024, MT = NP + NSR, DEPTH = 4, NPROJ = 5376, INDIM = 5136;
constexpr int SEQ = 2048, DSEQ = 8, BATCH = 8, DBATCH = 128;
constexpr float EPS = 1e-6f;
constexpr int LDA2 = 2048 + 64, LDHB = 1024 + 64;
constexpr int PC_Z = 0, PC_X = 1024, PC_B = 2048, PC_C = 2560, PC_LX = 3072, PC_LG = 3584, PC_SU = 4096, PC_SG = 4608, PC_DT = 5120;
constexpr size_t O_YP = 0, O_YS = O_YP + (size_t)NP * D, O_SSDP = O_YS + (size_t)NSR * D, O_SSDS = O_SSDP + (size_t)DEPTH * BATCH * 16 * 64 * 128,
    O_SCP = O_SSDS + (size_t)DEPTH * DBATCH * 16 * 64 * 128, O_SCS = O_SCP + (size_t)DEPTH * BATCH * 3 * 2048, O_LRUP = O_SCS + (size_t)DEPTH * DBATCH * 3 * 2048,
    O_LRUS = O_LRUP + (size_t)DEPTH * BATCH * 512, O_LCP = O_LRUS + (size_t)DEPTH * DBATCH * 512, O_LCS = O_LCP + (size_t)DEPTH * BATCH * 3 * 512,
    O_S5RP = O_LCS + (size_t)DEPTH * DBATCH * 3 * 512, O_S5RS = O_S5RP + (size_t)DEPTH * BATCH * 2048, O_S5IP = O_S5RS + (size_t)DEPTH * DBATCH * 2048,
    O_S5IS = O_S5IP + (size_t)DEPTH * BATCH * 2048, O_END = O_S5IS + (size_t)DEPTH * DBATCH * 2048;
constexpr size_t WS_CTR = 0, WS_BAR = 4096, WS_WTIN = 4096 + 16384, WS_WTOUT = WS_WTIN + (size_t)DEPTH * NPROJ * LDHB * 2, WS_WTGLU = WS_WTOUT + (size_t)DEPTH * D * LDA2 * 2,
    WS_HB = WS_WTGLU + (size_t)DEPTH * 512 * 512 * 2, WS_PROJ = WS_HB + (size_t)MT * LDHB * 2, WS_DTRAW = WS_PROJ + (size_t)MT * NPROJ * 2,
    WS_A2 = WS_DTRAW + (size_t)MT * 16 * 4, WS_G5 = WS_A2 + (size_t)MT * LDA2 * 2, WS_XB = WS_G5 + (size_t)MT * 512 * 2, WS_SSQ = WS_XB + (size_t)MT * D * 4,
    WS_XBC = WS_SSQ + (size_t)MT * 32 * 4, WS_END = WS_XBC + (size_t)MT * 2048 * 2;
constexpr int LDS_BYTES = 131072 + 64;
constexpr int NPH = 1 + 6 * DEPTH;

struct Args { const float* in[35]; float* out; unsigned char* ws; int ph_lo, ph_hi; };
#define CAS __attribute__((address_space(4)))
typedef const CAS Args* AP;

__device__ __forceinline__ float bf2f(bf16_t v) { return __uint_as_float(((unsigned)v) << 16); }
typedef __bf16 bf16x2_t __attribute__((ext_vector_type(2)));
__device__ __forceinline__ unsigned pk2(float lo, float hi) { f32x2 v = {lo, hi}; bf16x2_t r = __builtin_convertvector(v, bf16x2_t); return __builtin_bit_cast(unsigned, r); }
__device__ __forceinline__ bf16_t f2bf(float f) { return (bf16_t)(pk2(f, 0.f) & 0xffffu); }
__device__ __forceinline__ float lo16(unsigned w) { return __uint_as_float(w << 16); }
__device__ __forceinline__ float hi16(unsigned w) { return __uint_as_float(w & 0xffff0000u); }
__device__ __forceinline__ float fexp(float x) { return __builtin_amdgcn_exp2f(x * 1.4426950408889634f); }
__device__ __forceinline__ float sigmoid_f(float x) { return __builtin_amdgcn_rcpf(1.f + fexp(-x)); }
__device__ __forceinline__ float silu_f(float x) { return x * __builtin_amdgcn_rcpf(1.f + fexp(-x)); }
__device__ __forceinline__ float softplus_f(float x) { return fmaxf(x, 0.f) + 0.6931471805599453f * __builtin_amdgcn_logf(1.f + fexp(-fabsf(x))); }
__device__ __forceinline__ float gelu_f(float x) { return x * sigmoid_f(1.5957691216057308f * (x + 0.044715f * x * x * x)); }
__device__ __forceinline__ float wave_sum(float v) {
#pragma unroll
    for (int o = 1; o < 64; o <<= 1) v += __shfl_xor(v, o);
    return v;
}

namespace pg8 {
#define PG8_LAS __attribute__((address_space(3)))
typedef unsigned short bf16_t;
typedef short bf16x8 __attribute__((ext_vector_type(8)));
typedef float f32x4 __attribute__((ext_vector_type(4)));
typedef unsigned u32x4 __attribute__((ext_vector_type(4)));
constexpr int BM = 256, BK = 64, HALF = 128, HTB = HALF * BK * 2  , STAGE_BYTES = 8 * HTB, NXCD = 8, WGM = 8;

__host__ __device__ __forceinline__ int lds_byte(int r, int c) { const int st = (r >> 4) * 2 + (c >> 5), rr = r & 15, cc = c & 31, ob = rr * 64 + cc * 2; return st * 1024 + (ob ^ (((ob >> 9) & 1) << 5)); }
__host__ __device__ __forceinline__ void stage_rc(int b, int& R, int& C) { const int st = b / 1024, sb = b % 1024, swz = sb ^ (((sb >> 9) & 1) << 5); R = (st >> 1) * 16 + swz / 64; C = (st & 1) * 32 + (swz % 64) / 2; }
__host__ __device__ __forceinline__ int perm32(int rho) { const int n = rho >> 4, i = rho & 15; return 8 * (i >> 2) + 4 * n + (i & 3); }

struct Unit { int pm, pn; };
struct Gemm { const bf16_t* A; const bf16_t* Bt; int M, N, K, lda, ldb; };

struct StaticOrder {
    int nM, nN, nwg, G, c;
    __host__ __device__ void init(int M, int N, int G_, int c_) { nM = M / BM; nN = N / BM; nwg = nM * nN; G = G_; c = c_; }
    __host__ __device__ bool next(int i, Unit& u) const {
        const long L = (long)i * G + c; if (L >= nwg) return false;
        int wgid = (int)L; { const int q = nwg / NXCD, r = nwg % NXCD, xcd = wgid % NXCD, off = wgid / NXCD; wgid = (xcd < r ? xcd * (q + 1) : r * (q + 1) + (xcd - r) * q) + off; }
        const int nig = WGM * nN, gid = wgid / nig, fm = gid * WGM, gsz = (nM - fm) < WGM ? (nM - fm) : WGM;
        u.pm = fm + ((wgid % nig) % gsz); u.pn = (wgid % nig) / gsz; return true;
    }
    __device__ __forceinline__ void a_ready(const Unit&) const {}
    __device__ __forceinline__ void done(const Unit&) const {}
};

__device__ __forceinline__ unsigned cvt_pk_bf16(float lo, float hi) { return pk2(lo, hi); }
struct EpiProj {
    static constexpr bool PERM = true, AFTER_DRAIN = false;
    bf16_t* O; int ldc;
    __device__ __forceinline__ void operator()(const f32x4 (&acc)[2][2][4][2], const Unit& u, int wr, int wc, int fr, int fq) const {
        const int row0 = u.pm * BM + wr * 64 + fr, col0 = u.pn * BM + wc * 32 + 8 * fq;
#pragma unroll
        for (int ai = 0; ai < 2; ++ai)
#pragma unroll
            for (int m = 0; m < 4; ++m) { bf16_t* rowp = O + (size_t)(row0 + ai * HALF + m * 16) * ldc + col0;
#pragma unroll
                for (int bj = 0; bj < 2; ++bj) { const f32x4 v0 = acc[ai][bj][m][0], v1 = acc[ai][bj][m][1];
                    u32x4 w; w.x = cvt_pk_bf16(v0[0], v0[1]); w.y = cvt_pk_bf16(v0[2], v0[3]); w.z = cvt_pk_bf16(v1[0], v1[1]); w.w = cvt_pk_bf16(v1[2], v1[3]);
                    *(u32x4*)(rowp + bj * HALF) = w; } }
    }
};
struct EpiGlu {
    static constexpr bool PERM = true, AFTER_DRAIN = false;
    const bf16_t* G5; const bf16_t* proj; bf16_t* A2; const float* bias;
    __device__ __forceinline__ void operator()(const f32x4 (&acc)[2][2][4][2], const Unit& u, int wr, int wc, int fr, int fq) const {
        const int row0 = u.pm * BM + wr * 64 + fr, col0 = u.pn * BM + wc * 32 + 8 * fq;
#pragma unroll
        for (int bj = 0; bj < 2; ++bj) {
            const int col = col0 + bj * HALF;
            const f32x4 b0 = *(const f32x4*)(bias + col), b1 = *(const f32x4*)(bias + col + 4);
#pragma unroll
            for (int ai = 0; ai < 2; ++ai)
#pragma unroll
                for (int m = 0; m < 4; ++m) { const size_t row = (size_t)(row0 + ai * HALF + m * 16);
                    const u32x4 g = *(const u32x4*)(G5 + row * 512 + col); const u32x4 s = *(const u32x4*)(proj + row * NPROJ + PC_SG + col);
                    const f32x4 v0 = acc[ai][bj][m][0] + b0, v1 = acc[ai][bj][m][1] + b1;
                    float o[8];
                    o[0] = lo16(g.x) * sigmoid_f(v0[0]) * silu_f(lo16(s.x)); o[1] = hi16(g.x) * sigmoid_f(v0[1]) * silu_f(hi16(s.x));
                    o[2] = lo16(g.y) * sigmoid_f(v0[2]) * silu_f(lo16(s.y)); o[3] = hi16(g.y) * sigmoid_f(v0[3]) * silu_f(hi16(s.y));
                    o[4] = lo16(g.z) * sigmoid_f(v1[0]) * silu_f(lo16(s.z)); o[5] = hi16(g.z) * sigmoid_f(v1[1]) * silu_f(hi16(s.z));
                    o[6] = lo16(g.w) * sigmoid_f(v1[2]) * silu_f(lo16(s.w)); o[7] = hi16(g.w) * sigmoid_f(v1[3]) * silu_f(hi16(s.w));
                    u32x4 w; w.x = cvt_pk_bf16(o[0], o[1]); w.y = cvt_pk_bf16(o[2], o[3]); w.z = cvt_pk_bf16(o[4], o[5]); w.w = cvt_pk_bf16(o[6], o[7]);
                    *(u32x4*)(A2 + row * LDA2 + 1536 + col) = w; }
        }
    }
};
struct EpiRes {
    static constexpr bool PERM = false, AFTER_DRAIN = false;
    const float* srcP; const float* srcS; float* xout; int row_off;
    __device__ __forceinline__ void operator()(const f32x4 (&acc)[2][2][4][2], const Unit& u, int wr, int wc, int fr, int fq) const {
        const int row0 = row_off + u.pm * BM + wr * 64 + fr, col0 = u.pn * BM + wc * 32 + 4 * fq;
        const float* sb = (row_off + u.pm * BM < NP) ? srcP : (srcS - (size_t)NP * D);
#pragma unroll
        for (int ai = 0; ai < 2; ++ai)
#pragma unroll
            for (int m = 0; m < 4; ++m) { const size_t ro = (size_t)(row0 + ai * HALF + m * 16) * D + col0;
#pragma unroll
                for (int bj = 0; bj < 2; ++bj)
#pragma unroll
                    for (int n = 0; n < 2; ++n) { const f32x4 r = *(const f32x4*)(sb + ro + bj * HALF + n * 16); *(f32x4*)(xout + ro + bj * HALF + n * 16) = acc[ai][bj][m][n] + r; } }
    }
};
struct EpiPart {
    static constexpr bool PERM = false, AFTER_DRAIN = false;
    float* part;
    __device__ __forceinline__ void operator()(const f32x4 (&acc)[2][2][4][2], const Unit& u, int wr, int wc, int fr, int fq) const {
        const int row0 = u.pm * BM + wr * 64 + fr, col0 = u.pn * BM + wc * 32 + 4 * fq;
#pragma unroll
        for (int ai = 0; ai < 2; ++ai)
#pragma unroll
            for (int m = 0; m < 4; ++m) { const size_t ro = (size_t)(row0 + ai * HALF + m * 16) * D + col0;
#pragma unroll
                for (int bj = 0; bj < 2; ++bj)
#pragma unroll
                    for (int n = 0; n < 2; ++n) *(f32x4*)(part + ro + bj * HALF + n * 16) = acc[ai][bj][m][n]; }
    }
};

template <class Epi, class Sched, bool ALIGN_EPI = false, bool SP2 = false>
__device__ __forceinline__ void gemm_phase(PG8_LAS unsigned char* lds, const Gemm g, const Sched& S, const Epi& E) {
    int tid_ = threadIdx.x; asm volatile("" : "+v"(tid_)); const int tid = tid_, wid = __builtin_amdgcn_readfirstlane(tid >> 6), lane = tid & 63, wr = wid >> 2, wc = wid & 3, fr = lane & 15, fq = lane >> 4;
    const int K = g.K, nt = K / BK;
    unsigned voffA[2], voffB[2];
#pragma unroll
    for (int i = 0; i < 2; ++i) { int R, C; stage_rc(tid * 16 + i * 8192, R, C); const int Rb = Epi::PERM ? ((R & ~31) + perm32(R & 31)) : R;
        voffA[i] = (unsigned)(R * g.lda + C) * 2u; voffB[i] = (unsigned)(Rb * g.ldb + C) * 2u; }
    const size_t kstep = (size_t)(BK * 2);
    const size_t hstepA = (size_t)HALF * g.lda * 2, hstepB = (size_t)HALF * g.ldb * 2;
    const size_t tstepA = 2 * hstepA, tstepB = 2 * hstepB;
    const unsigned ldsw = (unsigned)wid * 1024u;
    const int aoff = lds_byte(wr * 64 + fr, fq * 8), boff = lds_byte(wc * 32 + fr, fq * 8);
#define PG8_SA(b, h) (((b) * 2 + (h)) * HTB)
#define PG8_SB(b, h) ((4 + (b) * 2 + (h)) * HTB)
#define PG8_STAGE(bufoff, gbase, voff) do { _Pragma("unroll") for (int _i = 0; _i < 2; ++_i) \
        __builtin_amdgcn_global_load_lds((const unsigned*)((const char*)(gbase) + (voff)[_i]), (PG8_LAS unsigned*)(lds + (bufoff) + ldsw + _i * 8192), 16, 0, 0); } while (0)
#define PG8_LDA(dst, b, h) do { _Pragma("unroll") for (int m = 0; m < 4; ++m) _Pragma("unroll") for (int k = 0; k < 2; ++k) dst[m][k] = *(const PG8_LAS bf16x8*)(lds + PG8_SA(b, h) + aoff + m * 2048 + k * 1024); } while (0)
#define PG8_LDB(dst, b, h) do { _Pragma("unroll") for (int n = 0; n < 2; ++n) _Pragma("unroll") for (int k = 0; k < 2; ++k) dst[n][k] = *(const PG8_LAS bf16x8*)(lds + PG8_SB(b, h) + boff + n * 2048 + k * 1024); } while (0)
#define PG8_MMA(ai, bj, At, Bt) do { __builtin_amdgcn_s_setprio(1); _Pragma("unroll") for (int m = 0; m < 4; ++m) _Pragma("unroll") for (int n = 0; n < 2; ++n) _Pragma("unroll") for (int k = 0; k < 2; ++k) \
        acc[ai][bj][m][n] = __builtin_amdgcn_mfma_f32_16x16x32_bf16(Bt[n][k], At[m][k], acc[ai][bj][m][n], 0, 0, 0); __builtin_amdgcn_s_setprio(0); } while (0)
#define PG8_WAIT_V(n) asm volatile("s_waitcnt vmcnt(" #n ")" ::: "memory")
#define PG8_WAIT_L(n) asm volatile("s_waitcnt lgkmcnt(" #n ")" ::: "memory")
#define PG8_BAR __builtin_amdgcn_s_barrier()
#define PG8_SCHED __builtin_amdgcn_sched_barrier(0)
    Unit cur, nxt; int ui = 0;
    if (!S.next(0, cur)) return;
    f32x4 acc[2][2][4][2];
#pragma unroll
    for (int a = 0; a < 2; ++a)
#pragma unroll
        for (int b = 0; b < 2; ++b)
#pragma unroll
            for (int m = 0; m < 4; ++m)
#pragma unroll
                for (int n = 0; n < 2; ++n) acc[a][b][m][n] = (f32x4){0.f, 0.f, 0.f, 0.f};
    bf16x8 At[4][2], B0[2][2], B1[2][2];
    const char* cA = (const char*)g.A + (size_t)cur.pm * tstepA; const char* cB = (const char*)g.Bt + (size_t)cur.pn * tstepB;
    S.a_ready(cur);
    if constexpr (SP2) {
        PG8_STAGE(PG8_SB(0, 0), cB, voffB); PG8_STAGE(PG8_SB(0, 1), cB + hstepB, voffB); PG8_STAGE(PG8_SA(0, 0), cA, voffA); PG8_STAGE(PG8_SA(0, 1), cA + hstepA, voffA);
        if (wr == 1) PG8_BAR;
        PG8_WAIT_V(2); PG8_BAR;
        PG8_STAGE(PG8_SB(1, 0), cB + kstep, voffB); PG8_STAGE(PG8_SA(1, 0), cA + kstep, voffA); PG8_STAGE(PG8_SB(1, 1), cB + hstepB + kstep, voffB);
        PG8_WAIT_V(6); PG8_BAR;
    } else {
        PG8_STAGE(PG8_SB(0, 0), cB, voffB); PG8_STAGE(PG8_SA(0, 0), cA, voffA); PG8_STAGE(PG8_SB(0, 1), cB + hstepB, voffB); PG8_STAGE(PG8_SA(0, 1), cA + hstepA, voffA);
        if (wr == 1) PG8_BAR;
        PG8_WAIT_V(4); PG8_BAR;
        PG8_STAGE(PG8_SB(1, 0), cB + kstep, voffB); PG8_STAGE(PG8_SA(1, 0), cA + kstep, voffA); PG8_STAGE(PG8_SB(1, 1), cB + hstepB + kstep, voffB);
        PG8_WAIT_V(6); PG8_BAR;
    }
    for (;;) {
        const bool has_next = S.next(ui + 1, nxt);
        const char* nA = has_next ? (const char*)g.A + (size_t)nxt.pm * tstepA : cA; const char* nB = has_next ? (const char*)g.Bt + (size_t)nxt.pn * tstepB : cB;
        for (int t = 0; t < nt; t += 2) {
            const bool last = (t == nt - 2);
            const char* a1 = cA + (size_t)(t + 1) * kstep;
            const char* a2 = last ? nA : cA + (size_t)(t + 2) * kstep; const char* b2 = last ? nB : cB + (size_t)(t + 2) * kstep;
            const char* a3 = a2 + kstep; const char* b3 = b2 + kstep;
            if (last && has_next) S.a_ready(nxt);
            if constexpr (SP2) {
            PG8_LDB(B0, 0, 0); PG8_LDB(B1, 0, 1); PG8_SCHED; PG8_LDA(At, 0, 0); PG8_STAGE(PG8_SA(1, 1), a1 + hstepA, voffA);
            PG8_WAIT_V(8); PG8_WAIT_L(0); PG8_BAR; PG8_MMA(0, 0, At, B0); PG8_MMA(0, 1, At, B1); PG8_BAR; PG8_SCHED;
            PG8_LDA(At, 0, 1); PG8_STAGE(PG8_SB(0, 0), b2, voffB); PG8_STAGE(PG8_SB(0, 1), b2 + hstepB, voffB); PG8_STAGE(PG8_SA(0, 0), a2, voffA);
            PG8_WAIT_V(8); PG8_WAIT_L(0); PG8_BAR; PG8_MMA(1, 0, At, B0); PG8_MMA(1, 1, At, B1); PG8_BAR; PG8_SCHED;
            PG8_LDB(B0, 1, 0); PG8_LDB(B1, 1, 1); PG8_SCHED; PG8_LDA(At, 1, 0); PG8_STAGE(PG8_SA(0, 1), a2 + hstepA, voffA);
            PG8_WAIT_V(8); PG8_WAIT_L(0); PG8_BAR; PG8_MMA(0, 0, At, B0); PG8_MMA(0, 1, At, B1); PG8_BAR; PG8_SCHED;
            PG8_LDA(At, 1, 1); PG8_STAGE(PG8_SB(1, 0), b3, voffB); PG8_STAGE(PG8_SB(1, 1), b3 + hstepB, voffB); PG8_STAGE(PG8_SA(1, 0), a3, voffA);
            PG8_WAIT_V(8); PG8_WAIT_L(0); PG8_BAR; PG8_MMA(1, 0, At, B0); PG8_MMA(1, 1, At, B1); PG8_BAR; PG8_SCHED;
            } else {
            PG8_LDB(B0, 0, 0); PG8_SCHED; PG8_LDA(At, 0, 0); PG8_STAGE(PG8_SA(1, 1), a1 + hstepA, voffA);
            PG8_WAIT_L(8); PG8_BAR; PG8_WAIT_L(0); PG8_MMA(0, 0, At, B0); PG8_BAR; PG8_SCHED;
            PG8_LDB(B1, 0, 1); PG8_STAGE(PG8_SB(0, 0), b2, voffB);
            PG8_BAR; PG8_WAIT_L(0); PG8_MMA(0, 1, At, B1); PG8_BAR;
            PG8_LDA(At, 0, 1); PG8_STAGE(PG8_SA(0, 0), a2, voffA);
            PG8_BAR; PG8_WAIT_L(0); PG8_MMA(1, 0, At, B0); PG8_BAR; PG8_SCHED;
            PG8_STAGE(PG8_SB(0, 1), b2 + hstepB, voffB);
            PG8_WAIT_V(6); PG8_BAR; PG8_MMA(1, 1, At, B1); PG8_BAR;
            PG8_LDB(B0, 1, 0); PG8_SCHED; PG8_LDA(At, 1, 0); PG8_STAGE(PG8_SA(0, 1), a2 + hstepA, voffA);
            PG8_WAIT_L(8); PG8_BAR; PG8_WAIT_L(0); PG8_MMA(0, 0, At, B0); PG8_BAR; PG8_SCHED;
            PG8_LDB(B1, 1, 1); PG8_STAGE(PG8_SB(1, 0), b3, voffB);
            PG8_BAR; PG8_WAIT_L(0); PG8_MMA(0, 1, At, B1); PG8_BAR;
            PG8_LDA(At, 1, 1); PG8_STAGE(PG8_SA(1, 0), a3, voffA);
            PG8_BAR; PG8_WAIT_L(0); PG8_MMA(1, 0, At, B0); PG8_BAR; PG8_SCHED;
            PG8_STAGE(PG8_SB(1, 1), b3 + hstepB, voffB);
            PG8_WAIT_V(6); PG8_BAR; PG8_MMA(1, 1, At, B1); PG8_BAR;
            }
        }
        if constexpr (ALIGN_EPI) { if (wr == 0) PG8_BAR; }
        if constexpr (!Epi::AFTER_DRAIN) { E(acc, cur, wr, wc, fr, fq); S.done(cur); }
        if (!has_next) break;
#pragma unroll
        for (int a = 0; a < 2; ++a)
#pragma unroll
            for (int b = 0; b < 2; ++b)
#pragma unroll
                for (int m = 0; m < 4; ++m)
#pragma unroll
                    for (int n = 0; n < 2; ++n) acc[a][b][m][n] = (f32x4){0.f, 0.f, 0.f, 0.f};
        cur = nxt; cA = nA; cB = nB; ++ui;
        if constexpr (ALIGN_EPI) { if (wr == 1) PG8_BAR; }
    }
    PG8_WAIT_V(0);
    if constexpr (!ALIGN_EPI) { if (wr == 0) PG8_BAR; }
    PG8_BAR;
    if constexpr (Epi::AFTER_DRAIN) { E.fused(acc, cur, wr, wc, fr, fq, lds, wid, lane); S.done(cur); }
#undef PG8_SA
#undef PG8_SB
#undef PG8_STAGE
#undef PG8_LDA
#undef PG8_LDB
#undef PG8_MMA
#undef PG8_WAIT_V
#undef PG8_WAIT_L
#undef PG8_BAR
#undef PG8_SCHED
}
}

__device__ __forceinline__ void transpose_item(const float* src, int ldw, int k0, int sc0, bf16_t* dst, int dstK, int n0, const float* kscale, LAS float* scr, int lane, int valid = 32) {
    float v[32];
    const bool ok = (lane & 31) < valid; const int cl = ok ? (lane & 31) : 0;
#pragma unroll
    for (int i = 0; i < 32; ++i) { const int kk = 2 * i + (lane >> 5); const float t_ = src[(size_t)(k0 + kk) * ldw + sc0 + cl]; v[i] = ok ? t_ : 0.f; }
    if (kscale) {
#pragma unroll
        for (int i = 0; i < 32; ++i) v[i] *= kscale[k0 + 2 * i + (lane >> 5)]; }
#pragma unroll
    for (int i = 0; i < 32; ++i) scr[(2 * i + (lane >> 5)) * 33 + (lane & 31)] = v[i];
    asm volatile("s_waitcnt lgkmcnt(0)" ::: "memory");
    const int c = lane & 7;
#pragma unroll
    for (int j = 0; j < 4; ++j) { const int n = (lane >> 3) + 8 * j; const LAS float* s = scr + (8 * c) * 33 + n;
        u32x4 o; o.x = pk2(s[0], s[33]); o.y = pk2(s[2 * 33], s[3 * 33]); o.z = pk2(s[4 * 33], s[5 * 33]); o.w = pk2(s[6 * 33], s[7 * 33]);
        *(u32x4*)(dst + (size_t)(n0 + n) * dstK + k0 + 8 * c) = o; }
    asm volatile("s_waitcnt lgkmcnt(0)" ::: "memory");
}
__device__ __forceinline__ void p0_phase(AP a, LAS unsigned char* lds) {
    int tid_ = threadIdx.x; asm volatile("" : "+v"(tid_)); const int lane = tid_ & 63, w = __builtin_amdgcn_readfirstlane(tid_ >> 6);
    LAS float* scr = (LAS float*)lds + w * (64 * 33 + 32);
    constexpr int I_IN = 16 * 168, I_OUT = 32 * 32, I_GLU = 8 * 16, I_L = I_IN + I_OUT + I_GLU;
    for (int it = blockIdx.x * 8 + w; it < DEPTH * I_L; it += gridDim.x * 8) {
        const int l = it / I_L; int r = it % I_L;
        if (r < I_IN) { const int kb = r / 168, nb = r % 168, n0 = nb * 32;
            const int sc0 = n0 < 3072 ? n0 : (n0 < 5120 ? n0 + 16 : 3072), valid = n0 < 5120 ? 32 : (n0 == 5120 ? 16 : 0);
            transpose_item(a->in[9] + (size_t)l * D * INDIM, INDIM, kb * 64, sc0, (bf16_t*)(a->ws + WS_WTIN) + (size_t)l * NPROJ * LDHB, LDHB, n0, nullptr, scr, lane, valid); continue; }
        r -= I_IN;
        if (r < I_OUT) { const int kb = r / 32, nb = r % 32;
            transpose_item(a->in[33] + (size_t)l * 2048 * D, D, kb * 64, nb * 32, (bf16_t*)(a->ws + WS_WTOUT) + (size_t)l * D * LDA2, LDA2, nb * 32, (kb < 16) ? (a->in[15] + l * 1024) : nullptr, scr, lane); continue; }
        r -= I_OUT;
        { const int kb = r / 16, nb = r % 16;
            transpose_item(a->in[31] + (size_t)l * 512 * 512, 512, kb * 64, nb * 32, (bf16_t*)(a->ws + WS_WTGLU) + (size_t)l * 512 * 512, 512, nb * 32, nullptr, scr, lane); }
    }
    __syncthreads();
}
__device__ __forceinline__ void norm_phase(AP a, int l, int row_lo, int row_hi, int blk_lo, int nblk, const float* part = nullptr, const float* resP = nullptr, const float* resS = nullptr) {
    int tid_ = threadIdx.x; asm volatile("" : "+v"(tid_)); const int tid = tid_, lane = tid & 63, w = tid >> 6;
    const int bi = (int)blockIdx.x - blk_lo; if (bi < 0 || bi >= nblk) return;
    const float* srcP = (l == 0) ? a->in[0] : (const float*)(a->ws + WS_XB);
    const float* srcS = (l == 0) ? a->in[1] : (const float*)(a->ws + WS_XB) + (size_t)NP * D;
    const float* g = (l < DEPTH) ? (a->in[8] + l * D) : a->in[34];
    f32x4 gv[4];
#pragma unroll
    for (int j = 0; j < 4; ++j) gv[j] = *(const f32x4*)(g + 4 * lane + 256 * j);
    bf16_t* hb = (bf16_t*)(a->ws + WS_HB);
    const int stride = nblk * 8;
    for (int row = row_lo + bi * 8 + w; row < row_hi; row += 2 * stride) {
        const int row2 = row + stride; const bool has2 = row2 < row_hi; const int r2 = has2 ? row2 : row;
        const float* xr = (row < NP) ? (srcP + (size_t)row * D) : (srcS + (size_t)(row - NP) * D);
        const float* xq = (r2 < NP) ? (srcP + (size_t)r2 * D) : (srcS + (size_t)(r2 - NP) * D);
        f32x4 v[4], q[4]; float s = 0.f, s2 = 0.f;
#pragma unroll
        for (int j = 0; j < 4; ++j) { v[j] = *(const f32x4*)(xr + 4 * lane + 256 * j); q[j] = *(const f32x4*)(xq + 4 * lane + 256 * j); }
        if (part) {
            const float* r0 = resS + (size_t)(row - NP) * D; const float* r1 = resS + (size_t)(r2 - NP) * D;
            float* xo0 = (float*)(a->ws + WS_XB) + (size_t)row * D; float* xo1 = (float*)(a->ws + WS_XB) + (size_t)r2 * D;
#pragma unroll
            for (int j = 0; j < 4; ++j) { const int c = 4 * lane + 256 * j; f32x4 s0 = *(const f32x4*)(r0 + c), s1 = *(const f32x4*)(r1 + c);
#pragma unroll
                for (int ks = 0; ks < 4; ++ks) { s0 += *(const f32x4*)(part + ((size_t)ks * NSR + (row - NP)) * D + c); s1 += *(const f32x4*)(part + ((size_t)ks * NSR + (r2 - NP)) * D + c); }
                v[j] = s0; q[j] = s1; *(f32x4*)(xo0 + c) = s0; if (has2) *(f32x4*)(xo1 + c) = s1; }
        }
#pragma unroll
        for (int j = 0; j < 4; ++j) { s += (v[j].x * v[j].x + v[j].y * v[j].y) + (v[j].z * v[j].z + v[j].w * v[j].w); s2 += (q[j].x * q[j].x + q[j].y * q[j].y) + (q[j].z * q[j].z + q[j].w * q[j].w); }
        const float rs = rsqrtf(wave_sum(s) * (1.f / D) + EPS), rs2 = rsqrtf(wave_sum(s2) * (1.f / D) + EPS);
#pragma unroll
        for (int j = 0; j < 4; ++j) { v[j] = v[j] * rs * gv[j]; q[j] = q[j] * rs2 * gv[j]; }
        if (l < DEPTH) {
#pragma unroll
            for (int j = 0; j < 4; ++j) { u32x2 o; o.x = pk2(v[j].x, v[j].y); o.y = pk2(v[j].z, v[j].w); *(u32x2*)(hb + (size_t)row * LDHB + 4 * lane + 256 * j) = o; }
            if (has2) {
#pragma unroll
                for (int j = 0; j < 4; ++j) { u32x2 o; o.x = pk2(q[j].x, q[j].y); o.y = pk2(q[j].z, q[j].w); *(u32x2*)(hb + (size_t)row2 * LDHB + 4 * lane + 256 * j) = o; } }
        } else {
#pragma unroll
            for (int j = 0; j < 4; ++j) *(f32x4*)(a->out + O_YP + (size_t)row * D + 4 * lane + 256 * j) = v[j];
            if (has2) {
#pragma unroll
                for (int j = 0; j < 4; ++j) *(f32x4*)(a->out + O_YP + (size_t)row2 * D + 4 * lane + 256 * j) = q[j]; }
        }
    }
}
__device__ __forceinline__ void ssdnorm_rows(AP a, int blk_lo, int nblk) {
    int tid_ = threadIdx.x; asm volatile("" : "+v"(tid_)); const int tid = tid_, lane = tid & 63, w = tid >> 6;
    bf16_t* A2 = (bf16_t*)(a->ws + WS_A2); const float* ssq = (const float*)(a->ws + WS_SSQ);
    const int bi = (int)blockIdx.x - blk_lo; if (bi < 0 || bi >= nblk) return;
    const int stride = nblk * 8;
    for (int row = bi * 8 + w; row < MT; row += 2 * stride) {
        const int row2 = row + stride; const bool has2 = row2 < MT; const int r2 = has2 ? row2 : row;
        float s = (lane < 32) ? ssq[(size_t)row * 32 + lane] : 0.f, t = (lane < 32) ? ssq[(size_t)r2 * 32 + lane] : 0.f;
        u32x4* p0 = (u32x4*)(A2 + (size_t)row * LDA2 + 8 * lane); u32x4* p1 = (u32x4*)(A2 + (size_t)r2 * LDA2 + 8 * lane);
        u32x4 va = p0[0], vb = p0[64], vc = p1[0], vd = p1[64];
        const float rs = rsqrtf(wave_sum(s) * (1.f / 1024.f) + EPS), rt = rsqrtf(wave_sum(t) * (1.f / 1024.f) + EPS);
#define SN_SCALE(v, r) do { v.x = pk2(lo16(v.x) * r, hi16(v.x) * r); v.y = pk2(lo16(v.y) * r, hi16(v.y) * r); v.z = pk2(lo16(v.z) * r, hi16(v.z) * r); v.w = pk2(lo16(v.w) * r, hi16(v.w) * r); } while (0)
        SN_SCALE(va, rs); SN_SCALE(vb, rs); p0[0] = va; p0[64] = vb;
        if (has2) { SN_SCALE(vc, rt); SN_SCALE(vd, rt); p1[0] = vc; p1[64] = vd; }
#undef SN_SCALE
    }
}

__device__ __forceinline__ void conv_phase(AP a, int l) {
    asm volatile("" : "+s"(a));
    int tid_ = threadIdx.x; asm volatile("" : "+v"(tid_)); const int tid = tid_;
    const bf16_t* proj = (const bf16_t*)(a->ws + WS_PROJ); bf16_t* XBC = (bf16_t*)(a->ws + WS_XBC);
    const int col = tid & 255, c8 = col * 8;
    float wk[4][8], bs[8];
    { const float* cw = a->in[10] + (size_t)l * 4 * 2048 + c8; const float* cb = a->in[11] + l * 2048 + c8;
#pragma unroll
      for (int k = 0; k < 4; ++k) { const f32x4 w0 = *(const f32x4*)(cw + k * 2048), w1 = *(const f32x4*)(cw + k * 2048 + 4);
          wk[k][0] = w0.x; wk[k][1] = w0.y; wk[k][2] = w0.z; wk[k][3] = w0.w; wk[k][4] = w1.x; wk[k][5] = w1.y; wk[k][6] = w1.z; wk[k][7] = w1.w; }
      const f32x4 b0 = *(const f32x4*)cb, b1 = *(const f32x4*)(cb + 4); bs[0] = b0.x; bs[1] = b0.y; bs[2] = b0.z; bs[3] = b0.w; bs[4] = b1.x; bs[5] = b1.y; bs[6] = b1.z; bs[7] = b1.w; }
#define CV_UNPACK(dst, r) do { dst[0] = lo16(r.x); dst[1] = hi16(r.x); dst[2] = lo16(r.y); dst[3] = hi16(r.y); dst[4] = lo16(r.z); dst[5] = hi16(r.z); dst[6] = lo16(r.w); dst[7] = hi16(r.w); } while (0)
#define CV_OUT(dstp, x0, x1, x2, x3) do { float o_[8]; _Pragma("unroll") for (int e = 0; e < 8; ++e) o_[e] = silu_f(bs[e] + wk[0][e] * x0[e] + wk[1][e] * x1[e] + wk[2][e] * x2[e] + wk[3][e] * x3[e]); \
        u32x4 pk_; pk_.x = pk2(o_[0], o_[1]); pk_.y = pk2(o_[2], o_[3]); pk_.z = pk2(o_[4], o_[5]); pk_.w = pk2(o_[6], o_[7]); *(u32x4*)(dstp) = pk_; } while (0)
    for (int run = blockIdx.x * 2 + (tid >> 8); run < NP / 32; run += gridDim.x * 2) {
        const int r0 = run * 32; const bool first = (r0 % SEQ) == 0;
        const bf16_t* src = proj + (size_t)r0 * NPROJ + PC_X + c8; bf16_t* dst = XBC + (size_t)r0 * 2048 + c8;
        float xa[8], xb[8], xc[8], xd[8];
        if (first) {
#pragma unroll
            for (int e = 0; e < 8; ++e) { xa[e] = 0.f; xb[e] = 0.f; xc[e] = 0.f; }
        } else { const u32x4 ra = *(const u32x4*)(src - 3 * (size_t)NPROJ), rb = *(const u32x4*)(src - 2 * (size_t)NPROJ), rc = *(const u32x4*)(src - (size_t)NPROJ); CV_UNPACK(xa, ra); CV_UNPACK(xb, rb); CV_UNPACK(xc, rc); }
        u32x4 n0 = *(const u32x4*)(src), n1 = *(const u32x4*)(src + (size_t)NPROJ), n2 = *(const u32x4*)(src + (size_t)2 * NPROJ), n3 = *(const u32x4*)(src + (size_t)3 * NPROJ);
#pragma unroll 1
        for (int t = 0; t < 32; t += 4) {
            const u32x4 q0 = n0, q1 = n1, q2 = n2, q3 = n3;
            if (t + 4 < 32) { n0 = *(const u32x4*)(src + (size_t)(t + 4) * NPROJ); n1 = *(const u32x4*)(src + (size_t)(t + 5) * NPROJ); n2 = *(const u32x4*)(src + (size_t)(t + 6) * NPROJ); n3 = *(const u32x4*)(src + (size_t)(t + 7) * NPROJ); }
            CV_UNPACK(xd, q0); CV_OUT(dst + (size_t)(t + 0) * 2048, xa, xb, xc, xd);
            CV_UNPACK(xa, q1); CV_OUT(dst + (size_t)(t + 1) * 2048, xb, xc, xd, xa);
            CV_UNPACK(xb, q2); CV_OUT(dst + (size_t)(t + 2) * 2048, xc, xd, xa, xb);
            CV_UNPACK(xc, q3); CV_OUT(dst + (size_t)(t + 3) * 2048, xd, xa, xb, xc);
        }
        if ((r0 % SEQ) == SEQ - 32) {
            float* co = a->out + O_SCP + ((size_t)l * BATCH + r0 / SEQ) * 3 * 2048 + c8;
            *(f32x4*)(co) = (f32x4){xa[0], xa[1], xa[2], xa[3]}; *(f32x4*)(co + 4) = (f32x4){xa[4], xa[5], xa[6], xa[7]};
            *(f32x4*)(co + 2048) = (f32x4){xb[0], xb[1], xb[2], xb[3]}; *(f32x4*)(co + 2048 + 4) = (f32x4){xb[4], xb[5], xb[6], xb[7]};
            *(f32x4*)(co + 4096) = (f32x4){xc[0], xc[1], xc[2], xc[3]}; *(f32x4*)(co + 4096 + 4) = (f32x4){xc[4], xc[5], xc[6], xc[7]}; }
    }
    for (int sq = blockIdx.x * 2 + (tid >> 8); sq < DBATCH; sq += gridDim.x * 2) {
        const int r0 = NP + sq * DSEQ;
        const bf16_t* src = proj + (size_t)r0 * NPROJ + PC_X + c8; bf16_t* dst = XBC + (size_t)r0 * 2048 + c8;
        const float* cst = a->in[3] + ((size_t)l * DBATCH + sq) * 3 * 2048 + c8;
        float xa[8], xb[8], xc[8], xd[8];
        { const f32x4 a0 = *(const f32x4*)cst, a1 = *(const f32x4*)(cst + 4), b0 = *(const f32x4*)(cst + 2048), b1 = *(const f32x4*)(cst + 2048 + 4), c0 = *(const f32x4*)(cst + 4096), c1 = *(const f32x4*)(cst + 4096 + 4);
          xa[0] = a0.x; xa[1] = a0.y; xa[2] = a0.z; xa[3] = a0.w; xa[4] = a1.x; xa[5] = a1.y; xa[6] = a1.z; xa[7] = a1.w;
          xb[0] = b0.x; xb[1] = b0.y; xb[2] = b0.z; xb[3] = b0.w; xb[4] = b1.x; xb[5] = b1.y; xb[6] = b1.z; xb[7] = b1.w;
          xc[0] = c0.x; xc[1] = c0.y; xc[2] = c0.z; xc[3] = c0.w; xc[4] = c1.x; xc[5] = c1.y; xc[6] = c1.z; xc[7] = c1.w; }
#pragma unroll 1
        for (int t = 0; t < 8; t += 4) {
            const u32x4 q0 = *(const u32x4*)(src + (size_t)(t + 0) * NPROJ), q1 = *(const u32x4*)(src + (size_t)(t + 1) * NPROJ), q2 = *(const u32x4*)(src + (size_t)(t + 2) * NPROJ), q3 = *(const u32x4*)(src + (size_t)(t + 3) * NPROJ);
            CV_UNPACK(xd, q0); CV_OUT(dst + (size_t)(t + 0) * 2048, xa, xb, xc, xd);
            CV_UNPACK(xa, q1); CV_OUT(dst + (size_t)(t + 1) * 2048, xb, xc, xd, xa);
            CV_UNPACK(xb, q2); CV_OUT(dst + (size_t)(t + 2) * 2048, xc, xd, xa, xb);
            CV_UNPACK(xc, q3); CV_OUT(dst + (size_t)(t + 3) * 2048, xd, xa, xb, xc);
        }
        { float* co = a->out + O_SCS + ((size_t)l * DBATCH + sq) * 3 * 2048 + c8;
            *(f32x4*)(co) = (f32x4){xa[0], xa[1], xa[2], xa[3]}; *(f32x4*)(co + 4) = (f32x4){xa[4], xa[5], xa[6], xa[7]};
            *(f32x4*)(co + 2048) = (f32x4){xb[0], xb[1], xb[2], xb[3]}; *(f32x4*)(co + 2048 + 4) = (f32x4){xb[4], xb[5], xb[6], xb[7]};
            *(f32x4*)(co + 4096) = (f32x4){xc[0], xc[1], xc[2], xc[3]}; *(f32x4*)(co + 4096 + 4) = (f32x4){xc[4], xc[5], xc[6], xc[7]}; }
    }
    { float* DT = (float*)(a->ws + WS_DTRAW); float dtb[16];
#pragma unroll
      for (int hd = 0; hd < 16; ++hd) dtb[hd] = a->in[12][l * 16 + hd];
      for (int row = blockIdx.x * 512 + tid; row < MT; row += gridDim.x * 512) {
          const u32x4 d0 = *(const u32x4*)(proj + (size_t)row * NPROJ + PC_DT), d1 = *(const u32x4*)(proj + (size_t)row * NPROJ + PC_DT + 8);
          float dv[16]; CV_UNPACK(dv, d0); { float* dv8 = dv + 8; CV_UNPACK(dv8, d1); }
#pragma unroll
          for (int hd = 0; hd < 16; ++hd) DT[(size_t)hd * MT + row] = softplus_f(dv[hd] + dtb[hd]); } }
#undef CV_UNPACK
#undef CV_OUT
}

#define LBAR() do { asm volatile("s_waitcnt lgkmcnt(0)" ::: "memory"); __builtin_amdgcn_s_barrier(); asm volatile("" ::: "memory"); } while (0)

typedef short bf16x8 __attribute__((ext_vector_type(8)));
constexpr int XT_S = 72, BC_S = 136;
__device__ __forceinline__ f32x4 mfma16(bf16x8 a, bf16x8 b, f32x4 c) { return __builtin_amdgcn_mfma_f32_16x16x32_bf16(a, b, c, 0, 0, 0); }
__device__ __forceinline__ void ssd_mfma_unit(AP a, int l, int b, int hd, LAS unsigned char* lds) {
    asm volatile("" : "+s"(a));
#define XTI(r_, t_) ((r_) * XT_S + ((t_) ^ ((((r_) >> 3) & 7) << 3)))
#define XTC(r_, c_) ((r_) * XT_S + ((((c_)) ^ (((r_) >> 3) & 7)) << 3))
    int tid_ = threadIdx.x; asm volatile("" : "+v"(tid_)); const int tid = tid_, w = __builtin_amdgcn_readfirstlane(tid >> 6);
    const int g = hd >> 2, row0 = b * SEQ;
    LAS bf16_t* Xt = (LAS bf16_t*)lds;
    LAS bf16_t* Xwt = Xt + 64 * XT_S;
    LAS bf16_t* Bs = Xwt + 64 * XT_S;
    LAS bf16_t* Cs = Bs + 64 * BC_S;
    LAS bf16_t* Bt = Cs + 64 * BC_S;
    LAS bf16_t* Ps = Bt + 128 * XT_S;
    LAS bf16_t* Hs0 = Ps + 64 * XT_S;
    LAS float* dts0 = (LAS float*)(Hs0 + 2 * 64 * BC_S);
    LAS float* acs0 = dts0 + 128;
    LAS bf16_t* Zs = (LAS bf16_t*)(acs0 + 128);
    const bf16_t* proj = (const bf16_t*)(a->ws + WS_PROJ); const bf16_t* XBC = (const bf16_t*)(a->ws + WS_XBC);
    bf16_t* A2 = (bf16_t*)(a->ws + WS_A2); float* ssq = (float*)(a->ws + WS_SSQ);
    const float aneg = -fexp(a->in[13][l * 16 + hd]), Dh = a->in[14][l * 16 + hd]; const float* DT = (const float*)(a->ws + WS_DTRAW);
    for (int idx = tid; idx < 64 * BC_S / 2; idx += 512) ((LAS unsigned*)Hs0)[idx] = 0u;
#define SSD_ITEM(j) const int i_ = tid + 512 * (j); const int t = i_ / 40, vc = i_ - t * 40
    u32x4 pre[5]; float dtr_a = 0.f, dtr_b = 0.f; u32x4 zpre;
    const int lane0 = tid & 63;
#define SSD_PREFETCH(t0_) do { _Pragma("unroll") for (int j = 0; j < 5; ++j) { SSD_ITEM(j); \
        const int col = vc < 8 ? hd * 64 + vc * 8 : (vc < 24 ? 1024 + g * 128 + (vc - 8) * 8 : 1536 + g * 128 + (vc - 24) * 8); \
        pre[j] = *(const u32x4*)(XBC + (size_t)(row0 + (t0_) + t) * 2048 + col); } \
        zpre = *(const u32x4*)(proj + (size_t)(row0 + (t0_) + (tid >> 3)) * NPROJ + PC_Z + hd * 64 + (tid & 7) * 8); \
        dtr_b = ((t0_) + 64 < SEQ) ? DT[(size_t)hd * MT + row0 + (t0_) + 64 + lane0] : 0.f; } while (0)
#define SSD_SCAN(dtv_, buf_) do { const float dt_ = (dtv_); float s_ = dt_ * aneg; \
        _Pragma("unroll") for (int o = 1; o < 64; o <<= 1) { const float t_ = __shfl_up(s_, o); if (lane0 >= o) s_ += t_; } \
        dts0[(buf_) * 64 + lane0] = dt_; acs0[(buf_) * 64 + lane0] = s_; } while (0)
    SSD_PREFETCH(0);
    if (w == 1) { const float d0 = DT[(size_t)hd * MT + row0 + lane0]; SSD_SCAN(d0, 0); }
    dtr_a = dtr_b;
    f32x4 hacc[4];
#pragma unroll
    for (int pt = 0; pt < 4; ++pt) hacc[pt] = (f32x4){0.f, 0.f, 0.f, 0.f};
    __syncthreads();
    for (int c = 0; c < SEQ / 64; ++c) {
        const int t0 = c * 64;
        int tl_ = tid; asm volatile("" : "+v"(tl_)); const int lane = tl_ & 63, fr = lane & 15, quad = lane >> 4;
        LAS bf16_t* Hcur = Hs0 + (c & 1) * 64 * BC_S; LAS bf16_t* Hnxt = Hs0 + ((c & 1) ^ 1) * 64 * BC_S;
        LAS float* dts = dts0 + (c & 1) * 64; LAS float* acs = acs0 + (c & 1) * 64;
        const float aend = acs[63];
        *(LAS u32x4*)(Zs + (tl_ >> 3) * XT_S + (tl_ & 7) * 8) = zpre;
#pragma unroll
        for (int j = 0; j < 5; ++j) { SSD_ITEM(j); const u32x4 r = pre[j];
            const int tsw = t ^ ((vc & 7) << 3);
            if (vc < 8) { const float wgt = fexp(aend - acs[t]) * dts[t]; LAS bf16_t* xp = Xt + (vc * 8) * XT_S + tsw; LAS bf16_t* wp = Xwt + (vc * 8) * XT_S + tsw;
                xp[0 * XT_S] = (bf16_t)(r.x & 0xffffu); xp[1 * XT_S] = (bf16_t)(r.x >> 16); xp[2 * XT_S] = (bf16_t)(r.y & 0xffffu); xp[3 * XT_S] = (bf16_t)(r.y >> 16);
                xp[4 * XT_S] = (bf16_t)(r.z & 0xffffu); xp[5 * XT_S] = (bf16_t)(r.z >> 16); xp[6 * XT_S] = (bf16_t)(r.w & 0xffffu); xp[7 * XT_S] = (bf16_t)(r.w >> 16);
                const unsigned s0 = pk2(lo16(r.x) * wgt, hi16(r.x) * wgt), s1 = pk2(lo16(r.y) * wgt, hi16(r.y) * wgt), s2 = pk2(lo16(r.z) * wgt, hi16(r.z) * wgt), s3 = pk2(lo16(r.w) * wgt, hi16(r.w) * wgt);
                wp[0 * XT_S] = (bf16_t)(s0 & 0xffffu); wp[1 * XT_S] = (bf16_t)(s0 >> 16); wp[2 * XT_S] = (bf16_t)(s1 & 0xffffu); wp[3 * XT_S] = (bf16_t)(s1 >> 16);
                wp[4 * XT_S] = (bf16_t)(s2 & 0xffffu); wp[5 * XT_S] = (bf16_t)(s2 >> 16); wp[6 * XT_S] = (bf16_t)(s3 & 0xffffu); wp[7 * XT_S] = (bf16_t)(s3 >> 16);
            } else if (vc < 24) { const int n0 = (vc - 8) * 8; LAS bf16_t* bp = Bt + n0 * XT_S + tsw;
                *(LAS u32x4*)(Bs + t * BC_S + n0) = r;
                bp[0 * XT_S] = (bf16_t)(r.x & 0xffffu); bp[1 * XT_S] = (bf16_t)(r.x >> 16); bp[2 * XT_S] = (bf16_t)(r.y & 0xffffu); bp[3 * XT_S] = (bf16_t)(r.y >> 16);
                bp[4 * XT_S] = (bf16_t)(r.z & 0xffffu); bp[5 * XT_S] = (bf16_t)(r.z >> 16); bp[6 * XT_S] = (bf16_t)(r.w & 0xffffu); bp[7 * XT_S] = (bf16_t)(r.w >> 16);
            } else { const int n0 = (vc - 24) * 8; *(LAS u32x4*)(Cs + t * BC_S + n0) = r; } }
        LBAR();
        const float dscan = dtr_a;
        if (c + 1 < SEQ / 64) { SSD_PREFETCH(t0 + 64); dtr_a = dtr_b; }
        if (w == 1 && c + 1 < SEQ / 64) SSD_SCAN(dscan, (c + 1) & 1);
        const int qt = w >> 1, q = qt * 16 + fr; const size_t rowq = (size_t)(row0 + t0 + q);
#pragma unroll
        for (int h2 = 0; h2 < 2; ++h2) { __builtin_amdgcn_sched_barrier(0); const int ti = 2 * w + h2, qt2 = ti >> 2, st = ti & 3; f32x4 acc = (f32x4){0.f, 0.f, 0.f, 0.f};
            if (st <= qt2) { bf16x8 av[4], bv[4];
#pragma unroll
                for (int kk = 0; kk < 4; ++kk) { av[kk] = *(const LAS bf16x8*)(Bs + (st * 16 + fr) * BC_S + kk * 32 + quad * 8); bv[kk] = *(const LAS bf16x8*)(Cs + (qt2 * 16 + fr) * BC_S + kk * 32 + quad * 8); }
#pragma unroll
                for (int kk = 0; kk < 4; ++kk) acc = mfma16(av[kk], bv[kk], acc); }
            const int q2 = qt2 * 16 + fr; const float aq = acs[q2]; float pv[4];
#pragma unroll
            for (int j = 0; j < 4; ++j) { const int s = st * 16 + quad * 4 + j; const float e = fexp(fminf(aq - acs[s], 0.f)) * dts[s]; pv[j] = (s <= q2) ? acc[j] * e : 0.f; }
            u32x2 pk; pk.x = pk2(pv[0], pv[1]); pk.y = pk2(pv[2], pv[3]); *(LAS u32x2*)(Ps + q2 * XT_S + st * 16 + quad * 4) = pk; }
        LBAR();
        { const float eq = fexp(acs[q]); float s2 = 0.f;
#pragma unroll
          for (int h2 = 0; h2 < 2; ++h2) { __builtin_amdgcn_sched_barrier(0); const int pt = (w & 1) * 2 + h2; f32x4 acc = (f32x4){0.f, 0.f, 0.f, 0.f};
              bf16x8 av[6], bv[6];
#pragma unroll
              for (int kk = 0; kk < 4; ++kk) { av[kk] = *(const LAS bf16x8*)(Hcur + (pt * 16 + fr) * BC_S + kk * 32 + quad * 8); bv[kk] = *(const LAS bf16x8*)(Cs + (qt * 16 + fr) * BC_S + kk * 32 + quad * 8); }
#pragma unroll
              for (int kk = 0; kk < 2; ++kk) { av[4 + kk] = *(const LAS bf16x8*)(Xt + XTC(pt * 16 + fr, kk * 4 + quad)); bv[4 + kk] = *(const LAS bf16x8*)(Ps + (qt * 16 + fr) * XT_S + kk * 32 + quad * 8); }
#pragma unroll
              for (int kk = 0; kk < 4; ++kk) acc = mfma16(av[kk], bv[kk], acc);
              acc = acc * eq;
#pragma unroll
              for (int kk = 0; kk < 2; ++kk) acc = mfma16(av[4 + kk], bv[4 + kk], acc);
              const int p0 = pt * 16 + quad * 4;
              const u32x2 zv = *(const LAS u32x2*)(Zs + q * XT_S + p0);
              const float z0 = lo16(zv.x), z1 = hi16(zv.x), z2 = lo16(zv.y), z3 = hi16(zv.y);
              const float u0 = (acc[0] + Dh * bf2f(Xt[XTI(p0 + 0, q)])) * silu_f(z0), u1 = (acc[1] + Dh * bf2f(Xt[XTI(p0 + 1, q)])) * silu_f(z1);
              const float u2 = (acc[2] + Dh * bf2f(Xt[XTI(p0 + 2, q)])) * silu_f(z2), u3 = (acc[3] + Dh * bf2f(Xt[XTI(p0 + 3, q)])) * silu_f(z3);
              s2 += (u0 * u0 + u1 * u1) + (u2 * u2 + u3 * u3);
              u32x2 o; o.x = pk2(u0, u1); o.y = pk2(u2, u3); *(u32x2*)(A2 + rowq * LDA2 + hd * 64 + p0) = o; }
          s2 += __shfl_xor(s2, 16); s2 += __shfl_xor(s2, 32);
          if (quad == 0) ssq[rowq * 32 + hd * 2 + (w & 1)] = s2; }
        { const float dec = fexp(aend);
          bf16x8 ea[2], eb[4][2];
#pragma unroll
          for (int kk = 0; kk < 2; ++kk) { ea[kk] = *(const LAS bf16x8*)(Bt + XTC(w * 16 + fr, kk * 4 + quad));
#pragma unroll
              for (int pt = 0; pt < 4; ++pt) eb[pt][kk] = *(const LAS bf16x8*)(Xwt + XTC(pt * 16 + fr, kk * 4 + quad)); }
#pragma unroll
          for (int pt = 0; pt < 4; ++pt) { f32x4 acc = hacc[pt] * dec;
#pragma unroll
              for (int kk = 0; kk < 2; ++kk) acc = mfma16(ea[kk], eb[pt][kk], acc);
              hacc[pt] = acc;
              u32x2 o; o.x = pk2(acc[0], acc[1]); o.y = pk2(acc[2], acc[3]); *(LAS u32x2*)(Hnxt + (pt * 16 + fr) * BC_S + w * 16 + quad * 4) = o; } }
        LBAR();
    }
#undef XTI
#undef XTC
#undef SSD_SCAN
#undef SSD_PREFETCH
#undef SSD_ITEM
    const int fr = tid & 15, quad = (tid & 63) >> 4;
#pragma unroll
    for (int pt = 0; pt < 4; ++pt) *(f32x4*)(a->out + O_SSDP + ((((size_t)l * BATCH + b) * 16 + hd) * 64 + pt * 16 + fr) * 128 + w * 16 + quad * 4) = hacc[pt];
}

__device__ __forceinline__ void ssd_sample_unit(AP a, int l, int b, int g, LAS unsigned char* lds) {
    asm volatile("" : "+s"(a));
    int tid_ = threadIdx.x; asm volatile("" : "+v"(tid_)); const int tid = tid_;
    const int row0 = NP + b * DSEQ;
    LAS float* xs = (LAS float*)lds;
    LAS float* Bs = xs + 2048;
    LAS float* Cs = Bs + 1024;
    LAS float* ys = Cs + 1024;
    LAS float* dts = ys + 2048;
    LAS float* dAs = dts + 32;
    const bf16_t* proj = (const bf16_t*)(a->ws + WS_PROJ); const bf16_t* XBC = (const bf16_t*)(a->ws + WS_XBC);
    bf16_t* A2 = (bf16_t*)(a->ws + WS_A2); float* ssq = (float*)(a->ws + WS_SSQ);
    const int p = tid >> 3, nq = tid & 7;
    float h[4][16];
#pragma unroll
    for (int hh = 0; hh < 4; ++hh) { const f32x4* s = (const f32x4*)(a->in[2] + ((((size_t)l * DBATCH + b) * 16 + g * 4 + hh) * 64 + p) * 128 + nq * 16);
#pragma unroll
        for (int j = 0; j < 4; ++j) { const f32x4 v = s[j]; h[hh][4 * j] = v.x; h[hh][4 * j + 1] = v.y; h[hh][4 * j + 2] = v.z; h[hh][4 * j + 3] = v.w; } }
    const int et = tid >> 6, ec = (tid & 63) * 4, eh = (tid & 63) >> 4;
    const u32x2 zz = *(const u32x2*)(proj + (size_t)(row0 + et) * NPROJ + PC_Z + g * 256 + ec);
    const float Dh = a->in[14][l * 16 + g * 4 + eh];
    { const int t = tid >> 6, vc = tid & 63;
        const int col = vc < 32 ? g * 256 + vc * 8 : (vc < 48 ? 1024 + g * 128 + (vc - 32) * 8 : 1536 + g * 128 + (vc - 48) * 8);
        const u32x4 r = *(const u32x4*)(XBC + (size_t)(row0 + t) * 2048 + col);
        LAS float* dst = vc < 32 ? xs + t * 256 + vc * 8 : (vc < 48 ? Bs + t * 128 + (vc - 32) * 8 : Cs + t * 128 + (vc - 48) * 8);
        *(LAS f32x4*)dst = (f32x4){lo16(r.x), hi16(r.x), lo16(r.y), hi16(r.y)}; *(LAS f32x4*)(dst + 4) = (f32x4){lo16(r.z), hi16(r.z), lo16(r.w), hi16(r.w)}; }
    if (tid < 32) { const int t = tid >> 2, hh = tid & 3, hd = g * 4 + hh; const float dt = ((const float*)(a->ws + WS_DTRAW))[(size_t)hd * MT + row0 + t];
        dts[tid] = dt; dAs[tid] = fexp(-dt * fexp(a->in[13][l * 16 + hd])); }
    LBAR();
#pragma unroll 1
    for (int t = 0; t < 8; ++t) {
        const LAS f32x4* B4 = (const LAS f32x4*)(Bs + t * 128 + nq * 16); const LAS f32x4* C4 = (const LAS f32x4*)(Cs + t * 128 + nq * 16);
        f32x4 bv[4], cv[4];
#pragma unroll
        for (int j = 0; j < 4; ++j) { bv[j] = B4[j]; cv[j] = C4[j]; }
#pragma unroll
        for (int hh = 0; hh < 4; ++hh) { const float dA = dAs[t * 4 + hh], dtx = dts[t * 4 + hh] * xs[t * 256 + hh * 64 + p]; float acc = 0.f;
#pragma unroll
            for (int j = 0; j < 4; ++j) {
                h[hh][4 * j] = dA * h[hh][4 * j] + dtx * bv[j].x; acc += cv[j].x * h[hh][4 * j];
                h[hh][4 * j + 1] = dA * h[hh][4 * j + 1] + dtx * bv[j].y; acc += cv[j].y * h[hh][4 * j + 1];
                h[hh][4 * j + 2] = dA * h[hh][4 * j + 2] + dtx * bv[j].z; acc += cv[j].z * h[hh][4 * j + 2];
                h[hh][4 * j + 3] = dA * h[hh][4 * j + 3] + dtx * bv[j].w; acc += cv[j].w * h[hh][4 * j + 3]; }
            acc += __shfl_xor(acc, 1); acc += __shfl_xor(acc, 2); acc += __shfl_xor(acc, 4);
            if (nq == 0) ys[t * 256 + hh * 64 + p] = acc; }
    }
#pragma unroll
    for (int hh = 0; hh < 4; ++hh) { f32x4* o = (f32x4*)(a->out + O_SSDS + ((((size_t)l * DBATCH + b) * 16 + g * 4 + hh) * 64 + p) * 128 + nq * 16);
#pragma unroll
        for (int j = 0; j < 4; ++j) { f32x4 v; v.x = h[hh][4 * j]; v.y = h[hh][4 * j + 1]; v.z = h[hh][4 * j + 2]; v.w = h[hh][4 * j + 3]; o[j] = v; } }
    LBAR();
    { const size_t row = (size_t)(row0 + et);
        const float z0 = lo16(zz.x), z1 = hi16(zz.x), z2 = lo16(zz.y), z3 = hi16(zz.y);
        const f32x4 yv = *(const LAS f32x4*)(ys + et * 256 + ec), xv = *(const LAS f32x4*)(xs + et * 256 + ec);
        const float u0 = (yv.x + Dh * xv.x) * silu_f(z0), u1 = (yv.y + Dh * xv.y) * silu_f(z1), u2 = (yv.z + Dh * xv.z) * silu_f(z2), u3 = (yv.w + Dh * xv.w) * silu_f(z3);
        float s2 = (u0 * u0 + u1 * u1) + (u2 * u2 + u3 * u3);
        u32x2 o; o.x = pk2(u0, u1); o.y = pk2(u2, u3); *(u32x2*)(A2 + row * LDA2 + g * 256 + ec) = o;
        s2 += __shfl_xor(s2, 1); s2 += __shfl_xor(s2, 2); s2 += __shfl_xor(s2, 4); s2 += __shfl_xor(s2, 8);
        if ((tid & 15) == 0) { ssq[row * 32 + (g * 4 + eh) * 2] = s2; ssq[row * 32 + (g * 4 + eh) * 2 + 1] = 0.f; } }
}

__device__ __forceinline__ void lru_unit(AP a, int l, bool isS, int bq, int k, LAS unsigned char* lds) {
    asm volatile("" : "+s"(a));
    int tid_ = threadIdx.x; asm volatile("" : "+v"(tid_)); const int tid = tid_, j = tid & 63, w = __builtin_amdgcn_readfirstlane(tid >> 6), ch = k * 64 + j;
    LAS bf16_t* Xr = (LAS bf16_t*)lds;
    LAS bf16_t* Wt = Xr + 64 * XT_S;
    LAS float* G = (LAS float*)(Wt + 128 * XT_S);
    LAS float* cA = G + 64 * 132;
    LAS float* cH = cA + 512;
    const bf16_t* proj = (const bf16_t*)(a->ws + WS_PROJ); bf16_t* A2 = (bf16_t*)(a->ws + WS_A2);
    { const float* wa = a->in[18] + (size_t)(l * 8 + k) * 4096; const float* wx = a->in[20] + (size_t)(l * 8 + k) * 4096;
      float ta[8], tx[8];
#pragma unroll
      for (int r = 0; r < 8; ++r) { ta[r] = wa[tid + 512 * r]; tx[r] = wx[tid + 512 * r]; }
#pragma unroll
      for (int r = 0; r < 8; ++r) { const int idx = tid + 512 * r, i = idx >> 6, jj = idx & 63; Wt[jj * XT_S + i] = f2bf(ta[r]); Wt[(64 + jj) * XT_S + i] = f2bf(tx[r]); } }
    const float ba = a->in[19][l * 512 + ch], bx = a->in[21][l * 512 + ch], sp = softplus_f(-a->in[22][l * 512 + ch]);
    const float cw0 = a->in[16][(l * 4 + 0) * 512 + ch], cw1 = a->in[16][(l * 4 + 1) * 512 + ch], cw2 = a->in[16][(l * 4 + 2) * 512 + ch], cw3 = a->in[16][(l * 4 + 3) * 512 + ch], cbias = a->in[17][l * 512 + ch];
    const int nb = isS ? DBATCH : BATCH;
    float H = 0.f, Hn = 0.f;
    const int ntile = isS ? DBATCH / 8 : SEQ / 64;
    bf16_t vr[11], gr[8]; float vf[3] = {0.f, 0.f, 0.f}; const unsigned choff = (unsigned)ch * 2u;
#define LRU_PREFETCH(ti_) do { const int bs_ = isS ? (ti_) * 8 + w : bq; const int ti0_ = isS ? 0 : (ti_) * 64 + w * 8; const size_t rw_ = (size_t)((isS ? NP + bs_ * DSEQ : bs_ * SEQ) + ti0_); \
        const float* cst_ = a->in[5] + (size_t)(l * DBATCH + bs_) * 3 * 512; \
        const char* bx_ = (const char*)proj + ((rw_ - 3) * NPROJ + PC_LX) * 2; const char* gx_ = (const char*)proj + (rw_ * NPROJ + PC_LG) * 2;     \
        if (isS) { _Pragma("unroll") for (int i = 0; i < 3; ++i) vf[i] = cst_[i * 512 + ch]; _Pragma("unroll") for (int i = 3; i < 11; ++i) vr[i] = *(const bf16_t*)(bx_ + (size_t)i * (NPROJ * 2) + choff); } \
        else if (ti0_ >= 3) { _Pragma("unroll") for (int i = 0; i < 11; ++i) vr[i] = *(const bf16_t*)(bx_ + (size_t)i * (NPROJ * 2) + choff); } \
        else { _Pragma("unroll") for (int i = 0; i < 11; ++i) { const int tk = ti0_ - 3 + i; vr[i] = (tk >= 0) ? *(const bf16_t*)(bx_ + (size_t)i * (NPROJ * 2) + choff) : (bf16_t)0; } } \
        _Pragma("unroll") for (int tl = 0; tl < 8; ++tl) gr[tl] = *(const bf16_t*)(gx_ + (size_t)tl * (NPROJ * 2) + choff); \
        if (isS) Hn = a->in[4][(size_t)(l * DBATCH + bs_) * 512 + ch]; } while (0)
    LRU_PREFETCH(0);
    for (int ti = 0; ti < ntile; ++ti) {
        int tl_ = tid; asm volatile("" : "+v"(tl_)); const int lane = tl_ & 63, fr = lane & 15, quad = lane >> 4;
        const int bseq = isS ? ti * 8 + w : bq; const int rowseq = isS ? NP + bseq * DSEQ : bseq * SEQ;
        const int ti0 = isS ? 0 : ti * 64 + w * 8; const size_t rw = (size_t)(rowseq + ti0);
        if (isS) H = Hn;
        float v[11], gt[8];
#pragma unroll
        for (int i = 0; i < 11; ++i) v[i] = (isS && i < 3) ? vf[i] : bf2f(vr[i]);
#pragma unroll
        for (int tl = 0; tl < 8; ++tl) gt[tl] = bf2f(gr[tl]);
        const float cs5 = v[8], cs6 = v[9], cs7 = v[10];
        float xr[8], gg[8];
#pragma unroll
        for (int tl = 0; tl < 8; ++tl) { xr[tl] = cbias + cw0 * v[tl] + cw1 * v[tl + 1] + cw2 * v[tl + 2] + cw3 * v[tl + 3]; gg[tl] = gt[tl]; Xr[(w * 8 + tl) * XT_S + lane] = f2bf(xr[tl]); }
        LBAR();
        if (ti + 1 < ntile) LRU_PREFETCH(ti + 1);
#pragma unroll
        for (int tt = 0; tt < 4; ++tt) { __builtin_amdgcn_sched_barrier(0); f32x4 acc = (f32x4){0.f, 0.f, 0.f, 0.f};
#pragma unroll
            for (int kk = 0; kk < 2; ++kk) { const bf16x8 av = *(const LAS bf16x8*)(Wt + (w * 16 + fr) * XT_S + kk * 32 + quad * 8); const bf16x8 bv = *(const LAS bf16x8*)(Xr + (tt * 16 + fr) * XT_S + kk * 32 + quad * 8);
                acc = mfma16(av, bv, acc); }
            *(LAS f32x4*)(G + (tt * 16 + fr) * 132 + w * 16 + quad * 4) = acc; }
        LBAR();
        float hl[8], Ap[8]; float hh = 0.f, aa = 1.f;
#pragma unroll
        for (int tl = 0; tl < 8; ++tl) { const float ra = G[(w * 8 + tl) * 132 + lane] + ba, rx = G[(w * 8 + tl) * 132 + 64 + lane] + bx;
            const float r = sigmoid_f(ra), gi = sigmoid_f(rx); const float la = -8.f * r * sp; const float at = fexp(la);
            const float gain = __builtin_amdgcn_sqrtf(fmaxf(1.f - at * at, 0.f)); const float bt = gain * gi * xr[tl];
            hh = at * hh + bt; aa *= at; hl[tl] = hh; Ap[tl] = aa; }
        float Hw = H, Hend;
        if (!isS) {
            cA[w * 64 + lane] = aa; cH[w * 64 + lane] = hh;
            LBAR();
            float Hin = H;
#pragma unroll
            for (int w2 = 0; w2 < 8; ++w2) { if (w2 == w) Hw = Hin; Hin = cA[w2 * 64 + lane] * Hin + cH[w2 * 64 + lane]; }
            Hend = Hin;
        } else Hend = hl[7] + Ap[7] * H;
        { char* ox = (char*)A2 + (rw * LDA2 + 1024) * 2;
#pragma unroll
          for (int tl = 0; tl < 8; ++tl) { const float hv = hl[tl] + Ap[tl] * Hw; *(bf16_t*)(ox + (size_t)tl * (LDA2 * 2) + choff) = f2bf(hv * silu_f(gg[tl])); } }
        H = Hend;
        if (isS) { a->out[O_LRUS + (size_t)(l * nb + bseq) * 512 + ch] = H;
            float* co = a->out + O_LCS + (size_t)(l * nb + bseq) * 3 * 512; co[ch] = cs5; co[512 + ch] = cs6; co[1024 + ch] = cs7; }
        LBAR();
    }
#undef LRU_PREFETCH
    if (!isS && w == 0) { a->out[O_LRUP + (size_t)(l * nb + bq) * 512 + ch] = H;
        float* co = a->out + O_LCP + (size_t)(l * nb + bq) * 3 * 512;
#pragma unroll
        for (int jj = 0; jj < 3; ++jj) co[jj * 512 + ch] = bf2f(proj[(size_t)(bq * SEQ + SEQ - 3 + jj) * NPROJ + PC_LX + ch]); }
}

__device__ __forceinline__ void s5_unit(AP a, int l, bool isS, int bq, int g, LAS unsigned char* lds) {
    asm volatile("" : "+s"(a));
    int tid_ = threadIdx.x; asm volatile("" : "+v"(tid_)); const int tid = tid_, p = tid & 63, w = __builtin_amdgcn_readfirstlane(tid >> 6);
    LAS float* us = (LAS float*)lds;
    LAS bf16_t* Hc = (LAS bf16_t*)(us + 1024);
    LAS bf16_t* Cc = Hc + 64 * BC_S;
    LAS float* cE = (LAS float*)(Cc + 16 * BC_S);
    LAS float* BU = cE + 1024;
    LAS bf16_t* Bb = (LAS bf16_t*)(BU + 128 * 68);
    LAS bf16_t* us16 = Bb + 128 * 16;
    LAS float* us2 = (LAS float*)(us16 + 2 * 1024);
    const bf16_t* proj = (const bf16_t*)(a->ws + WS_PROJ); bf16_t* G5 = (bf16_t*)(a->ws + WS_G5);
    const int lg = l * 32 + g;
    float ar, ai; float Bre[16], Bim[16];
    { const float delta = fexp(a->in[25][lg]); const float lr = a->in[23][(size_t)lg * 64 + p], li = a->in[24][(size_t)lg * 64 + p];
      const float mag = expf(lr * delta), ang = li * delta; ar = mag * cosf(ang); ai = mag * sinf(ang);
      const float den = lr * lr + li * li, nr = ar - 1.f, ni = ai; const float cr = (nr * lr + ni * li) / den, ci = (ni * lr - nr * li) / den;
      const f32x4* br = (const f32x4*)(a->in[26] + ((size_t)lg * 64 + p) * 16); const f32x4* bi = (const f32x4*)(a->in[27] + ((size_t)lg * 64 + p) * 16);
#pragma unroll
      for (int q = 0; q < 4; ++q) { const f32x4 r4 = br[q], i4 = bi[q];
          Bre[4 * q] = cr * r4.x - ci * i4.x; Bim[4 * q] = cr * i4.x + ci * r4.x; Bre[4 * q + 1] = cr * r4.y - ci * i4.y; Bim[4 * q + 1] = cr * i4.y + ci * r4.y;
          Bre[4 * q + 2] = cr * r4.z - ci * i4.z; Bim[4 * q + 2] = cr * i4.z + ci * r4.z; Bre[4 * q + 3] = cr * r4.w - ci * i4.w; Bim[4 * q + 3] = cr * i4.w + ci * r4.w; } }
    float pr[8], pi[8]; pr[0] = ar; pi[0] = ai;
#pragma unroll
    for (int q = 1; q < 8; ++q) { pr[q] = pr[q - 1] * ar - pi[q - 1] * ai; pi[q] = pr[q - 1] * ai + pi[q - 1] * ar; }
#pragma unroll
    for (int r = 0; r < 2; ++r) { const int idx = tid + 512 * r, h = idx >> 6, pp = idx & 63; Cc[h * BC_S + pp] = f2bf(a->in[28][(size_t)lg * 1024 + idx]); Cc[h * BC_S + 64 + pp] = f2bf(-a->in[29][(size_t)lg * 1024 + idx]); }
    if (w == 0) {
#pragma unroll
        for (int q = 0; q < 4; ++q) { u32x2 o; o.x = pk2(Bre[4 * q], Bre[4 * q + 1]); o.y = pk2(Bre[4 * q + 2], Bre[4 * q + 3]); *(LAS u32x2*)(Bb + p * 16 + 4 * q) = o;
            u32x2 o2; o2.x = pk2(Bim[4 * q], Bim[4 * q + 1]); o2.y = pk2(Bim[4 * q + 2], Bim[4 * q + 3]); *(LAS u32x2*)(Bb + (64 + p) * 16 + 4 * q) = o2; } }
    __syncthreads();
    typedef short bf16x4 __attribute__((ext_vector_type(4)));
    const bf16x4 breg = *(const LAS bf16x4*)(Bb + (w * 16 + (tid & 15)) * 16 + ((tid & 63) >> 4) * 4);
    const int nb = isS ? DBATCH : BATCH;
    float Hr = 0.f, Hi = 0.f, Hrn = 0.f, Hin_ = 0.f;
    if (isS) { Hrn = a->in[6][((size_t)(l * DBATCH + w) * 32 + g) * 64 + p]; Hin_ = a->in[7][((size_t)(l * DBATCH + w) * 32 + g) * 64 + p]; }
    const int ntile = isS ? DBATCH / 8 : SEQ / 64;
    f32x4 dv = *(const f32x4*)(a->in[30] + l * 512 + g * 16 + ((tid & 63) >> 4) * 4);
    const size_t rbase0 = isS ? (size_t)NP : (size_t)(bq * SEQ);
    u32x4 upre = (u32x4){0u, 0u, 0u, 0u};
    if ((unsigned)(tid - 256) < 128u) upre = *(const u32x4*)(proj + (rbase0 + ((tid - 256) >> 1)) * NPROJ + PC_SU + g * 16 + (tid & 1) * 8);
#define S5_STAGE(buf_) do { if ((unsigned)(tid - 256) < 128u) { const int st_ = tid - 256; LAS float* d = ((buf_) ? us2 : us) + (st_ >> 1) * 16 + (st_ & 1) * 8; f32x4 x0, x1; \
        x0.x = lo16(upre.x); x0.y = hi16(upre.x); x0.z = lo16(upre.y); x0.w = hi16(upre.y); x1.x = lo16(upre.z); x1.y = hi16(upre.z); x1.z = lo16(upre.w); x1.w = hi16(upre.w); \
        *(LAS f32x4*)d = x0; *(LAS f32x4*)(d + 4) = x1; *(LAS u32x4*)(us16 + (buf_) * 1024 + (st_ >> 1) * 16 + (st_ & 1) * 8) = upre; } } while (0)
    S5_STAGE(0);
    __syncthreads();
    for (int ti = 0; ti < ntile; ++ti) {
        int tl_ = tid; asm volatile("" : "+v"(tl_)); const int lane = tl_ & 63, fr = lane & 15, quad = lane >> 4;
        const size_t rbase = rbase0 + (size_t)ti * 64;
        const int cb = ti & 1; LAS float* usc = cb ? us2 : us; LAS bf16_t* us16c = us16 + cb * 1024;
        const int bseq = isS ? ti * 8 + w : bq;
        if (isS) { Hr = Hrn; Hi = Hin_; }

        if (ti + 1 < ntile && (unsigned)(tl_ - 256) < 128u) upre = *(const u32x4*)(proj + (rbase + 64 + ((tl_ - 256) >> 1)) * NPROJ + PC_SU + g * 16 + (tl_ & 1) * 8);
        if (isS && ti + 1 < ntile) { Hrn = a->in[6][((size_t)(l * DBATCH + (ti + 1) * 8 + w) * 32 + g) * 64 + p]; Hin_ = a->in[7][((size_t)(l * DBATCH + (ti + 1) * 8 + w) * 32 + g) * 64 + p]; }
#pragma unroll
        for (int tt = 0; tt < 4; ++tt) { const bf16x4 av = *(const LAS bf16x4*)(us16c + (tt * 16 + fr) * 16 + quad * 4);
            const f32x4 acc = __builtin_amdgcn_mfma_f32_16x16x16bf16_1k(av, breg, (f32x4){0.f, 0.f, 0.f, 0.f}, 0, 0, 0);
            *(LAS f32x4*)(BU + (w * 16 + fr) * 68 + tt * 16 + quad * 4) = acc; }
        LBAR();
        float hlr[8], hli[8]; float hr = 0.f, hi = 0.f;
        { const f32x4 r0 = *(const LAS f32x4*)(BU + lane * 68 + w * 8), r1 = *(const LAS f32x4*)(BU + lane * 68 + w * 8 + 4), i0 = *(const LAS f32x4*)(BU + (64 + lane) * 68 + w * 8), i1 = *(const LAS f32x4*)(BU + (64 + lane) * 68 + w * 8 + 4);
          const float bre[8] = {r0.x, r0.y, r0.z, r0.w, r1.x, r1.y, r1.z, r1.w}, bim[8] = {i0.x, i0.y, i0.z, i0.w, i1.x, i1.y, i1.z, i1.w};
#pragma unroll
          for (int tl = 0; tl < 8; ++tl) { const float nr_ = ar * hr - ai * hi + bre[tl], ni_ = ar * hi + ai * hr + bim[tl]; hr = nr_; hi = ni_; hlr[tl] = hr; hli[tl] = hi; } }
        float Hwr = Hr, Hwi = Hi, Her, Hei;
        if (!isS) {
            cE[(w * 64 + lane) * 2] = hr; cE[(w * 64 + lane) * 2 + 1] = hi;
            LBAR();
            float Hinr = Hr, Hini = Hi;
#pragma unroll
            for (int w2 = 0; w2 < 8; ++w2) { if (w2 == w) { Hwr = Hinr; Hwi = Hini; }
                const float er = cE[(w2 * 64 + lane) * 2], ei = cE[(w2 * 64 + lane) * 2 + 1];
                const float tr = pr[7] * Hinr - pi[7] * Hini + er, tq = pr[7] * Hini + pi[7] * Hinr + ei; Hinr = tr; Hini = tq; }
            Her = Hinr; Hei = Hini;
        } else { Her = hlr[7] + pr[7] * Hr - pi[7] * Hi; Hei = hli[7] + pr[7] * Hi + pi[7] * Hr; }
#pragma unroll
        for (int tl = 0; tl < 8; ++tl) { Hc[(w * 8 + tl) * BC_S + lane] = f2bf(hlr[tl] + pr[tl] * Hwr - pi[tl] * Hwi); Hc[(w * 8 + tl) * BC_S + 64 + lane] = f2bf(hli[tl] + pr[tl] * Hwi + pi[tl] * Hwr); }
        Hr = Her; Hi = Hei;
        if (isS) { a->out[O_S5RS + ((size_t)(l * nb + bseq) * 32 + g) * 64 + p] = Hr; a->out[O_S5IS + ((size_t)(l * nb + bseq) * 32 + g) * 64 + p] = Hi; }
        LBAR();
        if (ti + 1 < ntile) S5_STAGE(cb ^ 1);
        if (w < 4) { f32x4 acc = (f32x4){0.f, 0.f, 0.f, 0.f};
#pragma unroll
            for (int kk = 0; kk < 4; ++kk) { const bf16x8 av = *(const LAS bf16x8*)(Cc + fr * BC_S + kk * 32 + quad * 8); const bf16x8 bv = *(const LAS bf16x8*)(Hc + (w * 16 + fr) * BC_S + kk * 32 + quad * 8);
                acc = mfma16(av, bv, acc); }
            const int t = w * 16 + fr; const f32x4 uu = *(const LAS f32x4*)(usc + t * 16 + quad * 4);
            const float y0 = gelu_f(acc[0] + dv.x * uu.x), y1 = gelu_f(acc[1] + dv.y * uu.y), y2 = gelu_f(acc[2] + dv.z * uu.z), y3 = gelu_f(acc[3] + dv.w * uu.w);
            u32x2 o; o.x = pk2(y0, y1); o.y = pk2(y2, y3); *(u32x2*)(G5 + (rbase + t) * 512 + g * 16 + quad * 4) = o; }
        LBAR();
    }
    if (!isS && w == 0) { a->out[O_S5RP + ((size_t)(l * nb + bq) * 32 + g) * 64 + p] = Hr; a->out[O_S5IP + ((size_t)(l * nb + bq) * 32 + g) * 64 + p] = Hi; }
}
#undef S5_STAGE

constexpr int U_LRUP = 0, U_SSDP = U_LRUP + BATCH * 8, U_S5S = U_SSDP + BATCH * 16, U_LRUS = U_S5S + 32, U_S5P = U_LRUS + 8, U_SSDS = U_S5P + BATCH * 32, U_END = U_SSDS + DBATCH * 4;
__device__ __forceinline__ void mixer_phase(AP am, int l, LAS unsigned char* lds, int cidx, int ulo = 0, int uhi = U_END) {
    unsigned* ctr = (unsigned*)(am->ws + WS_CTR) + cidx * 64;
    LAS unsigned* slot = (LAS unsigned*)(lds + LDS_BYTES - 16);
    static_assert(U_LRUP == 0 && U_SSDP == 64 && U_S5S == 192, "static first round assumes LRU-P | SSD-P at the head of the queue");
    const bool stat = ((int)gridDim.x == 256) && ulo == 0 && uhi == U_END;
    bool first = stat && (int)blockIdx.x < 192;
    for (;;) {
        int u;
        if (first) { const int blk = (int)blockIdx.x, x = blk & 7; first = false;
            if (blk < 64) u = U_LRUP + x * 8 + (blk >> 3);
            else { const int j = (blk - 64) >> 3, pair = x * 4 + (j >> 2); u = U_SSDP + (pair >> 2) * 16 + (pair & 3) * 4 + (j & 3); }
        } else {
            if (threadIdx.x == 0) *slot = atomicAdd(ctr, 1u);
            __syncthreads();
            u = (int)*slot + (stat ? 192 : ulo);
            __syncthreads();
        }
        if (u >= uhi) break;
        AP a = am; asm volatile("" : "+s"(a));
        if (u < U_SSDP) lru_unit(a, l, false, (u - U_LRUP) >> 3, (u - U_LRUP) & 7, lds);
        else if (u < U_S5S) ssd_mfma_unit(a, l, (u - U_SSDP) >> 4, (u - U_SSDP) & 15, lds);
        else if (u < U_LRUS) s5_unit(a, l, true, 0, u - U_S5S, lds);
        else if (u < U_S5P) lru_unit(a, l, true, 0, u - U_LRUS, lds);
        else if (u < U_SSDS) s5_unit(a, l, false, (u - U_S5P) >> 5, (u - U_S5P) & 31, lds);
        else ssd_sample_unit(a, l, (u - U_SSDS) >> 2, (u - U_SSDS) & 3, lds);
        __syncthreads();
    }
}

#define XB_TMO      128
#define XB_XCNT(j)  (256  + 64 * (j))
#define XB_XSUB(j)  (1280 + 64 * (j))
#define XB_XGEN(j)  (2304 + 64 * (j))
#define XB_TOP      3328
#define XB_TOPGEN   3392
#define XCD_BAR_WORDS 3456
#define XB_SPIN_CAP (1u << 18)
__device__ __forceinline__ unsigned xb_ld(unsigned* p)              { return __hip_atomic_load(p, __ATOMIC_RELAXED, __HIP_MEMORY_SCOPE_AGENT); }
__device__ __forceinline__ unsigned xb_add(unsigned* p, unsigned v) { return __hip_atomic_fetch_add(p, v, __ATOMIC_RELAXED, __HIP_MEMORY_SCOPE_AGENT); }
__device__ __forceinline__ unsigned xb_xcc_id() { return (unsigned)__builtin_amdgcn_s_getreg((3 << 11) | 20) & 0xFu; }
#define XB_SPIN(cond, bar) do { unsigned _sp = 0; while (cond) { __builtin_amdgcn_s_sleep(1); \
    if ((++_sp & 255u) == 0u) { if (xb_ld(&(bar)[XB_TMO])) break; if (_sp > XB_SPIN_CAP) { atomicAdd(&(bar)[XB_TMO], 1u); break; } } } } while (0)
struct XcdBarrier { unsigned* bar; unsigned x; volatile LAS unsigned* st; };
__device__ __forceinline__ void xcd_barrier_complete(unsigned* bar, unsigned x, unsigned& nloc, unsigned& nx) {
    const unsigned G = gridDim.x * gridDim.y * gridDim.z;
    unsigned sum, cnt, mine, sp = 0u;
    for (;;) {
        sum = 0u; cnt = 0u; mine = 0u;
#pragma unroll
        for (unsigned j = 0; j < 16; ++j) { const unsigned c = xb_ld(&bar[XB_XCNT(j)]); sum += c; cnt += (c > 0u) ? 1u : 0u; mine = (j == x) ? c : mine; }
        if (sum == G) break;
        __builtin_amdgcn_s_sleep(1);
        if ((++sp & 255u) == 0u) { if (xb_ld(&bar[XB_TMO])) break; if (sp > XB_SPIN_CAP) { atomicAdd(&bar[XB_TMO], 1u); break; } }
    }
    nloc = mine > 0u ? mine : 1u; nx = cnt > 0u ? cnt : 1u;
}
__device__ __forceinline__ void xcd_barrier(const XcdBarrier& b) {
    asm volatile("s_waitcnt vmcnt(0)" ::: "memory");
    __syncthreads();
    if (threadIdx.x == 0) {
        unsigned* bar = b.bar;
        __builtin_amdgcn_s_waitcnt(0);
        unsigned nloc = b.st[0], nx = b.st[1];
        if (nloc == 0u) { xcd_barrier_complete(bar, b.x, nloc, nx); b.st[0] = nloc; b.st[1] = nx; }
        const unsigned old = xb_add(&bar[XB_XSUB(b.x)], 1u);
        const unsigned gen = old / nloc;
        if (old + 1u == (gen + 1u) * nloc) {
            __builtin_amdgcn_fence(__ATOMIC_RELEASE, "agent");
            asm volatile("s_waitcnt vmcnt(0)" ::: "memory");
            const unsigned og = xb_add(&bar[XB_TOP], 1u);
            const unsigned tg = og / nx;
            if (og + 1u == (tg + 1u) * nx) xb_add(&bar[XB_TOPGEN], 1u);
            else XB_SPIN(xb_ld(&bar[XB_TOPGEN]) == tg, bar);
            __builtin_amdgcn_fence(__ATOMIC_ACQUIRE, "agent");
            xb_add(&bar[XB_XGEN(b.x)], 1u);
            asm volatile("s_waitcnt vmcnt(0)" ::: "memory");
        } else {
            XB_SPIN(xb_ld(&bar[XB_XGEN(b.x)]) == gen, bar);
            __builtin_amdgcn_fence(__ATOMIC_ACQUIRE, "agent");
            asm volatile("s_waitcnt vmcnt(0)" ::: "memory");
        }
    }
    __syncthreads();
}

__global__ void __launch_bounds__(512, 2) mega(Args a_) {
    extern __shared__ __attribute__((aligned(16))) unsigned char smem[];
    LAS unsigned char* lds = (LAS unsigned char*)smem;
    cg::grid_group grid = cg::this_grid();
    AP a0 = (AP)__builtin_amdgcn_kernarg_segment_ptr();
    const int lo = a0->ph_lo, hi = a0->ph_hi;
    volatile LAS unsigned* xst = (volatile LAS unsigned*)(lds + 131072);
    if (threadIdx.x == 0) { xst[0] = 0u; xst[1] = 0u; (void)xb_add((unsigned*)(a0->ws + WS_BAR) + XB_XCNT(xb_xcc_id()), 1u); }
    __syncthreads();
#define IN(k) (lo <= (k) && (k) < hi)
#define SEAM(k) do { if (hi - lo > 1) { XcdBarrier xb_; xb_.bar = (unsigned*)(a0->ws + WS_BAR); xb_.x = xb_xcc_id(); xb_.st = xst; xcd_barrier(xb_); } } while (0)
#define FRESH(a) AP a = a0; asm volatile("" : "+s"(a))
    if (IN(0)) { { FRESH(a); p0_phase(a, lds); } { FRESH(a); norm_phase(a, 0, 0, MT, 0, (int)gridDim.x); } }
    if (hi < 0) grid.sync();
    SEAM(0);
#pragma unroll 1
    for (int l = 0; l < DEPTH; ++l) {
        const int pb = 1 + 6 * l;
        if (IN(pb)) {
            FRESH(a);
            pg8::Gemm g{(const bf16_t*)(a->ws + WS_HB), (const bf16_t*)(a->ws + WS_WTIN) + (size_t)l * NPROJ * LDHB, MT, NPROJ, D, LDHB, LDHB};
            pg8::StaticOrder S; S.init(MT, NPROJ, (int)gridDim.x, (int)blockIdx.x);
            pg8::EpiProj E{(bf16_t*)(a->ws + WS_PROJ), NPROJ};
            pg8::gemm_phase<pg8::EpiProj, pg8::StaticOrder, true, true>(lds, g, S, E);
        }
        SEAM(pb);
        if (IN(pb + 5)) { FRESH(a); conv_phase(a, l); }
        SEAM(pb + 5);
        if (IN(pb + 1)) { FRESH(a); mixer_phase(a, l, lds, l); }
        SEAM(pb + 1);
        if (IN(pb + 2)) {
            { FRESH(a);
            pg8::Gemm g{(const bf16_t*)(a->ws + WS_G5), (const bf16_t*)(a->ws + WS_WTGLU) + (size_t)l * 512 * 512, MT, 512, 512, 512, 512};
            pg8::StaticOrder S; S.init(MT, 512, (int)gridDim.x, (int)blockIdx.x);
            pg8::EpiGlu E{(const bf16_t*)(a->ws + WS_G5), (const bf16_t*)(a->ws + WS_PROJ), (bf16_t*)(a->ws + WS_A2), a->in[32] + l * 512};
            pg8::gemm_phase<pg8::EpiGlu, pg8::StaticOrder, true, true>(lds, g, S, E); }
            { FRESH(a); const int G = (int)gridDim.x; if (G > 200) ssdnorm_rows(a, 136, G - 136); else ssdnorm_rows(a, 0, G); }
        }
        SEAM(pb + 2);
        if (IN(pb + 3)) {
            FRESH(a);
            pg8::Gemm g{(const bf16_t*)(a->ws + WS_A2), (const bf16_t*)(a->ws + WS_WTOUT) + (size_t)l * D * LDA2, NP, D, 2048, LDA2, LDA2};
            pg8::StaticOrder S; S.init(NP, D, (int)gridDim.x, (int)blockIdx.x);
            pg8::EpiRes E{l == 0 ? a->in[0] : (const float*)(a->ws + WS_XB), l == 0 ? a->in[1] : (const float*)(a->ws + WS_XB) + (size_t)NP * D, (float*)(a->ws + WS_XB), 0};
            pg8::gemm_phase<pg8::EpiRes, pg8::StaticOrder, true, true>(lds, g, S, E);
        }
        SEAM(pb + 3);
        if (IN(pb + 4)) {
            const int G = (int)gridDim.x, ns = G > 128 ? 64 : 0;
            { FRESH(a);
            const int c = (int)blockIdx.x, ks = c & 3;
            pg8::Gemm g{(const bf16_t*)(a->ws + WS_A2) + (size_t)NP * LDA2 + ks * 512, (const bf16_t*)(a->ws + WS_WTOUT) + (size_t)l * D * LDA2 + ks * 512, NSR, D, 512, LDA2, LDA2};
            pg8::StaticOrder S; S.init(NSR, D, G, c < 64 ? (c >> 2) : 16);
            pg8::EpiPart E{(float*)(a->ws + WS_G5) + (size_t)ks * NSR * D};
            pg8::gemm_phase<pg8::EpiPart, pg8::StaticOrder, true, true>(lds, g, S, E); }
            { FRESH(a); norm_phase(a, l + 1, 0, NP, ns, G - ns); }
        }
        SEAM(pb + 4);
        { FRESH(a); norm_phase(a, l + 1, NP, MT, 0, (int)gridDim.x, (const float*)(a->ws + WS_G5), nullptr, l == 0 ? a->in[1] : (const float*)(a->ws + WS_XB) + (size_t)NP * D); }
        if (l + 1 < DEPTH) SEAM(pb + 4);
    }
#undef IN
#undef SEAM
}

#ifndef MK_PER_PHASE
#define MK_PER_PHASE 0
#endif
extern "C" void kernel_launch(void* const* d_in, const int* in_sizes, int n_in, void* d_out, int out_size, void* d_ws, size_t ws_size, hipStream_t stream) {
    static int grid = 0;
    if (grid == 0) {
        if (n_in != 35 || (size_t)out_size != O_END || ws_size < WS_END) { fprintf(stderr, "kernel_launch: unexpected shapes n_in %d out %d ws %zu (need %zu)\n", n_in, out_size, ws_size, (size_t)WS_END); grid = -1; return; }
        int dev = 0, cus = 0, per_cu = 0;
        if (hipGetDevice(&dev) != hipSuccess || hipDeviceGetAttribute(&cus, hipDeviceAttributeMultiprocessorCount, dev) != hipSuccess) { grid = -1; return; }
        if (hipFuncSetAttribute((const void*)mega, hipFuncAttributeMaxDynamicSharedMemorySize, LDS_BYTES) != hipSuccess) { fprintf(stderr, "kernel_launch: hipFuncSetAttribute failed\n"); grid = -1; return; }
        if (hipOccupancyMaxActiveBlocksPerMultiprocessor(&per_cu, (const void*)mega, 512, LDS_BYTES) != hipSuccess || per_cu < 1) fprintf(stderr, "kernel_launch: occupancy query says %d\n", per_cu);
        (void)hipGetLastError();
        grid = cus;
    }
    if (grid < 0) return;
    (void)hipMemsetAsync((char*)d_ws + WS_CTR, 0, 4096 + 16384, stream);
    Args a{};
    for (int i = 0; i < 35; ++i) a.in[i] = (const float*)d_in[i];
    a.out = (float*)d_out; a.ws = (unsigned char*)d_ws;
#if MK_PER_PHASE
    for (int ph = 0; ph < NPH; ++ph) { a.ph_lo = ph; a.ph_hi = ph + 1; hipLaunchKernelGGL(mega, dim3(grid), dim3(512), LDS_BYTES, stream, a); }
#else
    a.ph_lo = 0; a.ph_hi = NPH;
    void* args[] = {&a};
    const hipError_t e = hipLaunchCooperativeKernel((const void*)mega, dim3(grid), dim3(512), args, LDS_BYTES, stream);
    if (e != hipSuccess) fprintf(stderr, "kernel_launch: cooperative launch failed: %s (grid %d)\n", hipGetErrorString(e), grid);
#endif
}
```
